# Optimizing an MI355X kernel written in HIP

```python
import jax, jax.numpy as jnp
from jax import lax
import numpy as np

D_MODEL = 2048
BATCH = 2
SEQ = 8192
DEPTH = 2

HEAD_DIM = 128
BLOCK = 128
A_HEADS = D_MODEL // (2 * HEAD_DIM)
DILATED_GROUPS = ((128, 1), (512, 4), (2048, 16))
B_HEADS = D_MODEL // (2 * HEAD_DIM)
MLA_Q_LORA = 512
MLA_KV_LORA = 256
MLA_NOPE = 128
MLA_ROPE = 64
MLA_V = 128
C_HEADS = D_MODEL // HEAD_DIM
PEER_HEADS = 8
PEER_N_KEYS = 128
PEER_N_EXPERTS = PEER_N_KEYS * PEER_N_KEYS
PEER_TOPK = 16
PEER_QUERY_DIM = 256
PEER_HALF = PEER_QUERY_DIM // 2
PEER_CHUNK = 128
ROPE_THETA = 10000.0
LN_EPS = 1e-5
RMS_EPS = 1e-6
NEG_INF = -1e30
DN_ALPHA = (2 * DEPTH) ** 0.25
DN_BETA = (8 * DEPTH) ** -0.25
N_EVEN = (DEPTH + 1) // 2
N_ODD = DEPTH // 2
A_QKV = 3 * A_HEADS * HEAD_DIM
EVEN_IN = A_QKV + MLA_Q_LORA + MLA_KV_LORA + MLA_ROPE
EVEN_MIX = A_HEADS * HEAD_DIM + B_HEADS * MLA_V
ODD_IN = 3 * C_HEADS * HEAD_DIM
ODD_MIX = C_HEADS * HEAD_DIM

kernel_name = "hybrid_dilated_mla_stickbreak_peer_deepnorm"


def layer_norm(x, g, b):
    xf = x.astype(jnp.float32)
    mu = jnp.mean(xf, -1, keepdims=True)
    var = jnp.mean(jnp.square(xf - mu), -1, keepdims=True)
    y = (xf - mu) * lax.rsqrt(var + LN_EPS)
    return (y * g.astype(jnp.float32) + b.astype(jnp.float32)).astype(x.dtype)


def rms_norm(x, g):
    xf = x.astype(jnp.float32)
    y = xf * lax.rsqrt(jnp.mean(jnp.square(xf), -1, keepdims=True) + RMS_EPS)
    return (y * g.astype(jnp.float32)).astype(x.dtype)


def rope(x, pos):
    half = x.shape[-1] // 2
    inv = ROPE_THETA ** (-jnp.arange(half, dtype=jnp.float32) / half)
    ang = pos.astype(jnp.float32)[:, None] * inv[None, :]
    cos = jnp.cos(ang)[None, :, None, :]
    sin = jnp.sin(ang)[None, :, None, :]
    xf = x.astype(jnp.float32)
    x1, x2 = xf[..., :half], xf[..., half:]
    return jnp.concatenate([x1 * cos - x2 * sin, x1 * sin + x2 * cos], -1).astype(x.dtype)


def dilated_window_attention(q, k, v, dilation, steps):
    B, S, H, Dh = q.shape
    L = S // dilation
    Lp = -(-L // BLOCK) * BLOCK
    nb = Lp // BLOCK

    def to_sub(t):
        t = t.reshape(B, L, dilation, H, Dh).transpose(0, 2, 3, 1, 4)
        t = jnp.pad(t, ((0, 0), (0, 0), (0, 0), (0, Lp - L), (0, 0)))
        return t.reshape(B, dilation, H, nb, BLOCK, Dh)

    def with_prev(t):
        prev = jnp.pad(t, ((0, 0), (0, 0), (0, 0), (1, 0), (0, 0), (0, 0)))[:, :, :, :-1]
        return jnp.concatenate([prev, t], axis=4)

    qs = to_sub(q)
    kk = with_prev(to_sub(k))
    vv = with_prev(to_sub(v))
    logits = jnp.einsum('brhnqd,brhnkd->brhnqk', qs, kk).astype(jnp.float32) * (Dh ** -0.5)
    a = jnp.arange(BLOCK)[:, None]
    c = jnp.arange(2 * BLOCK)[None, :]
    rel = a + BLOCK - c
    band = (rel >= 0) & (rel <= steps)
    valid = (jnp.arange(nb)[:, None, None] > 0) | (c[None] >= BLOCK)
    mask = band[None] & valid
    logits = jnp.where(mask, logits, NEG_INF)
    m = jnp.max(logits, -1, keepdims=True)
    p = jnp.exp(logits - m)
    denom = jnp.sum(p, -1, keepdims=True)
    out = jnp.einsum('brhnqk,brhnkd->brhnqd', (p / denom).astype(v.dtype), vv)
    lse = (m + jnp.log(denom))[..., 0]
    out = out.reshape(B, dilation, H, Lp, Dh)[:, :, :, :L].transpose(0, 3, 1, 2, 4).reshape(B, S, H, Dh)
    lse = lse.reshape(B, dilation, H, Lp)[..., :L].transpose(0, 3, 1, 2).reshape(B, S, H)
    return out, lse


def causal_block_attention(q, k, v, scale):
    B, S, H, dq = q.shape
    nb = S // BLOCK
    qb = q.reshape(B, nb, BLOCK, H, dq).transpose(1, 0, 2, 3, 4)
    starts = jnp.arange(nb) * BLOCK
    kpos = jnp.arange(S)

    def one(args):
        qc, start = args
        s = jnp.einsum('bqhd,bkhd->bhqk', qc, k).astype(jnp.float32) * scale
        mask = kpos[None, :] <= (start + jnp.arange(BLOCK))[:, None]
        p = jax.nn.softmax(jnp.where(mask, s, NEG_INF), axis=-1)
        return jnp.einsum('bhqk,bkhd->bqhd', p.astype(v.dtype), v)

    out = lax.map(one, (qb, starts))
    return out.transpose(1, 0, 2, 3, 4).reshape(B, S, H, v.shape[-1])


def stick_breaking_attention(q, k, v):
    B, S, H, Dh = q.shape
    nb = S // BLOCK
    qb = q.reshape(B, nb, BLOCK, H, Dh).transpose(1, 0, 2, 3, 4)
    starts = jnp.arange(nb) * BLOCK
    kpos = jnp.arange(S)
    scale = Dh ** -0.5

    def one(args):
        qc, start = args
        z = jnp.einsum('bqhd,bkhd->bhqk', qc, k).astype(jnp.float32) * scale
        mask = kpos[None, :] < (start + jnp.arange(BLOCK))[:, None]
        log_beta = jax.nn.log_sigmoid(z)
        log_rest = jnp.where(mask, jax.nn.log_sigmoid(-z), 0.0)
        suffix = lax.cumsum(log_rest, axis=3, reverse=True) - log_rest
        att = jnp.where(mask, jnp.exp(log_beta + suffix), 0.0)
        return jnp.einsum('bhqk,bkhd->bqhd', att.astype(v.dtype), v)

    out = lax.map(one, (qb, starts))
    return out.transpose(1, 0, 2, 3, 4).reshape(B, S, H, Dh)


def even_mixer(x, w_in, q_norm, w_q_b, kv_norm, w_kv_b, w_out):
    B, S, _ = x.shape
    pos = jnp.arange(S)
    h = x @ w_in
    o1 = A_QKV
    o2 = o1 + MLA_Q_LORA
    o3 = o2 + MLA_KV_LORA
    qkv = h[..., :o1].reshape(B, S, 3, A_HEADS, HEAD_DIM)
    qa = rope(qkv[:, :, 0], pos)
    ka = rope(qkv[:, :, 1], pos)
    va = qkv[:, :, 2]
    outs, lses = [], []
    for window, dil in DILATED_GROUPS:
        o, l = dilated_window_attention(qa, ka, va, dil, window // dil)
        outs.append(o)
        lses.append(l)
    wts = jax.nn.softmax(jnp.stack(lses, 0), axis=0)
    out_a = jnp.sum(wts[..., None] * jnp.stack(outs, 0).astype(jnp.float32), 0).astype(x.dtype)
    c_q = rms_norm(h[..., o1:o2], q_norm)
    q = (c_q @ w_q_b).reshape(B, S, B_HEADS, MLA_NOPE + MLA_ROPE)
    q = jnp.concatenate([q[..., :MLA_NOPE], rope(q[..., MLA_NOPE:], pos)], -1)
    c_kv = rms_norm(h[..., o2:o3], kv_norm)
    kv = (c_kv @ w_kv_b).reshape(B, S, B_HEADS, MLA_NOPE + MLA_V)
    k_rope = rope(h[..., o3:].reshape(B, S, 1, MLA_ROPE), pos)
    k = jnp.concatenate([kv[..., :MLA_NOPE], jnp.broadcast_to(k_rope, (B, S, B_HEADS, MLA_ROPE))], -1)
    out_b = causal_block_attention(q, k, kv[..., MLA_NOPE:], (MLA_NOPE + MLA_ROPE) ** -0.5)
    cat = jnp.concatenate([out_a.reshape(B, S, -1), out_b.reshape(B, S, -1)], -1)
    return cat @ w_out


def odd_mixer(x, w_in, w_out):
    B, S, _ = x.shape
    qkv = (x @ w_in).reshape(B, S, 3, C_HEADS, HEAD_DIM)
    o = stick_breaking_attention(qkv[:, :, 0], qkv[:, :, 1], qkv[:, :, 2])
    return o.reshape(B, S, -1) @ w_out


def peer(x, w_query, sub_keys, u_table, v_table):
    B, S, D = x.shape
    xt = x.reshape(-1, PEER_CHUNK, D)

    def chunk(xc):
        T = xc.shape[0]
        q = (xc @ w_query).reshape(T, PEER_HEADS, 2, PEER_HALF)
        s1 = jnp.einsum('thk,hnk->thn', q[:, :, 0], sub_keys[:, 0]).astype(jnp.float32)
        s2 = jnp.einsum('thk,hnk->thn', q[:, :, 1], sub_keys[:, 1]).astype(jnp.float32)
        v1, i1 = lax.top_k(s1, PEER_TOPK)
        v2, i2 = lax.top_k(s2, PEER_TOPK)
        cand = (v1[..., :, None] + v2[..., None, :]).reshape(T, PEER_HEADS, PEER_TOPK * PEER_TOPK)
        cand_idx = (i1[..., :, None] * PEER_N_KEYS + i2[..., None, :]).reshape(T, PEER_HEADS, -1)
        top_s, sel = lax.top_k(cand, PEER_TOPK)
        idx = jnp.take_along_axis(cand_idx, sel, axis=-1)
        g = jax.nn.softmax(top_s, axis=-1)
        u = u_table[idx]
        act = jax.nn.gelu(jnp.einsum('thkd,td->thk', u, xc).astype(jnp.float32), approximate=False)
        vsel = v_table[idx]
        return jnp.einsum('thk,thkd->td', (g * act).astype(x.dtype), vsel)

    return lax.map(chunk, xt).reshape(B, S, D)


def setup_inputs(seed: int = 0) -> dict:
    key = jax.random.key(seed)
    ks = jax.random.split(key, 16)
    f32 = jnp.float32

    def nrm(k, shape, scale):
        return jax.random.normal(k, shape, f32) * scale

    return {
        "x": nrm(ks[0], (BATCH, SEQ, D_MODEL), 1.0),
        "a_w_in": nrm(ks[1], (N_EVEN, D_MODEL, EVEN_IN), D_MODEL ** -0.5),
        "b_q_norm": 1.0 + nrm(ks[2], (N_EVEN, MLA_Q_LORA), 0.01),
        "b_w_q_b": nrm(ks[3], (N_EVEN, MLA_Q_LORA, B_HEADS * (MLA_NOPE + MLA_ROPE)), MLA_Q_LORA ** -0.5),
        "b_kv_norm": 1.0 + nrm(ks[4], (N_EVEN, MLA_KV_LORA), 0.01),
        "b_w_kv_b": nrm(ks[5], (N_EVEN, MLA_KV_LORA, B_HEADS * (MLA_NOPE + MLA_V)), MLA_KV_LORA ** -0.5),
        "ab_w_out": nrm(ks[6], (N_EVEN, EVEN_MIX, D_MODEL), DN_BETA * EVEN_MIX ** -0.5),
        "c_w_in": nrm(ks[7], (N_ODD, D_MODEL, ODD_IN), D_MODEL ** -0.5),
        "c_w_out": nrm(ks[8], (N_ODD, ODD_MIX, D_MODEL), DN_BETA * ODD_MIX ** -0.5),
        "peer_w_query": nrm(ks[9], (DEPTH, D_MODEL, PEER_HEADS * PEER_QUERY_DIM), D_MODEL ** -0.5),
        "peer_sub_keys": nrm(ks[10], (DEPTH, PEER_HEADS, 2, PEER_N_KEYS, PEER_HALF), PEER_HALF ** -0.5),
        "peer_u": nrm(ks[11], (DEPTH, PEER_N_EXPERTS, D_MODEL), D_MODEL ** -0.5),
        "peer_v": nrm(ks[12], (DEPTH, PEER_N_EXPERTS, D_MODEL), DN_BETA),
        "ln_gain": 1.0 + nrm(ks[13], (DEPTH, 2, D_MODEL), 0.01),
        "ln_bias": nrm(ks[14], (DEPTH, 2, D_MODEL), 0.01),
    }


def reference(x, a_w_in, b_q_norm, b_w_q_b, b_kv_norm, b_w_kv_b, ab_w_out, c_w_in, c_w_out,
              peer_w_query, peer_sub_keys, peer_u, peer_v, ln_gain, ln_bias):
    for layer in range(DEPTH):
        i = layer // 2
        if layer % 2 == 0:
            mix = even_mixer(x, a_w_in[i], b_q_norm[i], b_w_q_b[i], b_kv_norm[i], b_w_kv_b[i], ab_w_out[i])
        else:
            mix = odd_mixer(x, c_w_in[i], c_w_out[i])
        x = layer_norm(DN_ALPHA * x + mix, ln_gain[layer, 0], ln_bias[layer, 0])
        ffn = peer(x, peer_w_query[layer], peer_sub_keys[layer], peer_u[layer], peer_v[layer])
        x = layer_norm(DN_ALPHA * x + ffn, ln_gain[layer, 1], ln_bias[layer, 1])
    return x
```

```cpp
#include <hip/hip_runtime.h>
#include <cstdio>
#include <cstdint>

namespace pg8 {
#define PG8_LAS __attribute__((address_space(3)))
typedef unsigned short bf16_t;
typedef short bf16x8 __attribute__((ext_vector_type(8)));
typedef float f32x4 __attribute__((ext_vector_type(4)));
typedef unsigned u32x4 __attribute__((ext_vector_type(4)));
typedef int pg8_i32x4 __attribute__((ext_vector_type(4)));
typedef int pg8_i32x8 __attribute__((ext_vector_type(8)));
constexpr int BM = 256, BK = 64, HALF = 128, HTB = HALF * BK * 2  , STAGE_BYTES = 8 * HTB, NXCD = 8, WGM = 4;

__host__ __device__ __forceinline__ int lds_byte(int r, int c) { const int st = (r >> 4) * 2 + (c >> 5), rr = r & 15, cc = c & 31, ob = rr * 64 + cc * 2; return st * 1024 + (ob ^ (((ob >> 9) & 1) << 5)); }
__host__ __device__ __forceinline__ void stage_rc(int b, int& R, int& C) { const int st = b / 1024, sb = b % 1024, swz = sb ^ (((sb >> 9) & 1) << 5); R = (st >> 1) * 16 + swz / 64; C = (st & 1) * 32 + (swz % 64) / 2; }
__host__ __device__ __forceinline__ int perm32(int rho) { const int n = rho >> 4, i = rho & 15; return 8 * (i >> 2) + 4 * n + (i & 3); }

struct Unit { int pm, pn; };
struct Gemm { const bf16_t* A; const bf16_t* Bt; int M, N, K, lda, ldb, apn, bpm; };

struct StaticOrder {
    int nM, nN, nwg, G, c;
    __host__ __device__ void init(int M, int N, int G_, int c_) { nM = M / BM; nN = N / BM; nwg = nM * nN; G = G_; c = c_; }
    __host__ __device__ bool next(int i, Unit& u) const {
        const long L = (long)i * G + c; if (L >= nwg) return false;
        int wgid = (int)L; { const int q = nwg / NXCD, r = nwg % NXCD, xcd = wgid % NXCD, off = wgid / NXCD; wgid = (xcd < r ? xcd * (q + 1) : r * (q + 1) + (xcd - r) * q) + off; }
        const int nig = WGM * nN, gid = wgid / nig, fm = gid * WGM, gsz = (nM - fm) < WGM ? (nM - fm) : WGM;
        u.pm = fm + ((wgid % nig) % gsz); u.pn = (wgid % nig) / gsz; return true;
    }
    __device__ __forceinline__ void a_ready(const Unit&) const {}
    __device__ __forceinline__ void done(const Unit&) const {}
};

__device__ __forceinline__ unsigned cvt_pk_bf16(float lo, float hi) { unsigned r; asm volatile("v_cvt_pk_bf16_f32 %0, %1, %2" : "=v"(r) : "v"(lo), "v"(hi)); return r; }
typedef float f32x2 __attribute__((ext_vector_type(2)));


struct EpiPlain {
    static constexpr bool PERM = true, AFTER_DRAIN = false;
    bf16_t* O; int ldc; float oscale;
    __device__ __forceinline__ void operator()(const f32x4 (&acc)[2][2][4][2], const Unit& u, int wr, int wc, int fr, int fq) const {
        int row0 = u.pm * BM + wr * 64 + fr, col0 = u.pn * BM + wc * 32 + 8 * fq; asm volatile("" : "+v"(row0), "+v"(col0));
#pragma unroll
        for (int ai = 0; ai < 2; ++ai)
#pragma unroll
            for (int m = 0; m < 4; ++m) { bf16_t* rowp = O + (size_t)(row0 + ai * HALF + m * 16) * ldc + col0;
#pragma unroll
                for (int bj = 0; bj < 2; ++bj) { const f32x4 v0 = acc[ai][bj][m][0] * oscale, v1 = acc[ai][bj][m][1] * oscale;
                    u32x4 w; w.x = cvt_pk_bf16(v0[0], v0[1]); w.y = cvt_pk_bf16(v0[2], v0[3]); w.z = cvt_pk_bf16(v1[0], v1[1]); w.w = cvt_pk_bf16(v1[2], v1[3]);
                    __builtin_nontemporal_store(w, (u32x4*)(rowp + bj * HALF)); } }
    }
};
struct EpiF32 {
    static constexpr bool PERM = false, AFTER_DRAIN = false;
    float* O; int ldc;
    __device__ __forceinline__ void operator()(const f32x4 (&acc)[2][2][4][2], const Unit& u, int wr, int wc, int fr, int fq) const {
        int row0 = u.pm * BM + wr * 64 + fr, col0 = u.pn * BM + wc * 32 + 4 * fq; asm volatile("" : "+v"(row0), "+v"(col0));
#pragma unroll
        for (int ai = 0; ai < 2; ++ai)
#pragma unroll
            for (int m = 0; m < 4; ++m) { float* rowp = O + (size_t)(row0 + ai * HALF + m * 16) * ldc + col0;
#pragma unroll
                for (int bj = 0; bj < 2; ++bj)
#pragma unroll
                    for (int n = 0; n < 2; ++n) *(f32x4*)(rowp + bj * HALF + n * 16) = acc[ai][bj][m][n]; }
    }
};
struct EpiRes {
    static constexpr bool PERM = false, AFTER_DRAIN = false;
    const float* R; float* O; int ldc; float alpha;
    __device__ __forceinline__ void operator()(const f32x4 (&acc)[2][2][4][2], const Unit& u, int wr, int wc, int fr, int fq) const {
        int row0 = u.pm * BM + wr * 64 + fr, col0 = u.pn * BM + wc * 32 + 4 * fq; asm volatile("" : "+v"(row0), "+v"(col0));
#pragma unroll
        for (int ai = 0; ai < 2; ++ai)
#pragma unroll
            for (int m = 0; m < 4; ++m) { const size_t off = (size_t)(row0 + ai * HALF + m * 16) * ldc + col0;
#pragma unroll
                for (int bj = 0; bj < 2; ++bj)
#pragma unroll
                    for (int n = 0; n < 2; ++n) { const f32x4 r = *(const f32x4*)(R + off + bj * HALF + n * 16); *(f32x4*)(O + off + bj * HALF + n * 16) = r * alpha + acc[ai][bj][m][n]; }
                asm volatile("" ::: "memory"); }
    }
};
struct EpiResB {
    static constexpr bool PERM = true, AFTER_DRAIN = false;
    const bf16_t* R; bf16_t* O; int ldc; float alpha;
    __device__ __forceinline__ void operator()(const f32x4 (&acc)[2][2][4][2], const Unit& u, int wr, int wc, int fr, int fq) const {
        int row0 = u.pm * BM + wr * 64 + fr, col0 = u.pn * BM + wc * 32 + 8 * fq; asm volatile("" : "+v"(row0), "+v"(col0));
#pragma unroll
        for (int ai = 0; ai < 2; ++ai)
#pragma unroll
            for (int m = 0; m < 4; ++m) { const size_t off = (size_t)(row0 + ai * HALF + m * 16) * ldc + col0;
#pragma unroll
                for (int bj = 0; bj < 2; ++bj) { const u32x4 rw = *(const u32x4*)(R + off + bj * HALF);
                    const f32x4 r0 = {__builtin_bit_cast(float, rw.x << 16), __builtin_bit_cast(float, rw.x & 0xffff0000u), __builtin_bit_cast(float, rw.y << 16), __builtin_bit_cast(float, rw.y & 0xffff0000u)};
                    const f32x4 r1 = {__builtin_bit_cast(float, rw.z << 16), __builtin_bit_cast(float, rw.z & 0xffff0000u), __builtin_bit_cast(float, rw.w << 16), __builtin_bit_cast(float, rw.w & 0xffff0000u)};
                    const f32x4 v0 = r0 * alpha + acc[ai][bj][m][0], v1 = r1 * alpha + acc[ai][bj][m][1];
                    u32x4 w; w.x = cvt_pk_bf16(v0[0], v0[1]); w.y = cvt_pk_bf16(v0[2], v0[3]); w.z = cvt_pk_bf16(v1[0], v1[1]); w.w = cvt_pk_bf16(v1[2], v1[3]);
                    __builtin_nontemporal_store(w, (u32x4*)(O + off + bj * HALF)); }
                asm volatile("" ::: "memory"); }
    }
};
__device__ __forceinline__ void rope8(f32x4& v0, f32x4& v1, const f32x4 c0, const f32x4 c1) {
    const f32x4 a = v0, b = v1;
    v0[0] = a[0] * c0[0] - a[1] * c0[1]; v0[1] = a[0] * c0[1] + a[1] * c0[0];
    v0[2] = a[2] * c0[2] - a[3] * c0[3]; v0[3] = a[2] * c0[3] + a[3] * c0[2];
    v1[0] = b[0] * c1[0] - b[1] * c1[1]; v1[1] = b[0] * c1[1] + b[1] * c1[0];
    v1[2] = b[2] * c1[2] - b[3] * c1[3]; v1[3] = b[2] * c1[3] + b[3] * c1[2];
}
struct EpiIn0 {
    static constexpr bool PERM = true, AFTER_DRAIN = false;
    bf16_t* O; int ldc; const float* T128; const float* T64; float* ssq; int seq;
    __device__ __forceinline__ void operator()(const f32x4 (&acc)[2][2][4][2], const Unit& u, int wr, int wc, int fr, int fq) const {
        int row0 = u.pm * BM + wr * 64 + fr, col0 = u.pn * BM + wc * 32 + 8 * fq; asm volatile("" : "+v"(row0), "+v"(col0));     const int pn = u.pn;
        const int pi0 = 16 * wc + 4 * fq;
#pragma unroll
        for (int ai = 0; ai < 2; ++ai)
#pragma unroll
            for (int m = 0; m < 4; ++m) { const int row = row0 + ai * HALF + m * 16; bf16_t* rowp = O + (size_t)row * ldc + col0; const int pos = row & (seq - 1);
                float sq = 0.f;
#pragma unroll
                for (int bj = 0; bj < 2; ++bj) { f32x4 v0 = acc[ai][bj][m][0], v1 = acc[ai][bj][m][1];
                    if (pn < 8) { const float* t = T128 + ((size_t)pos * 64 + pi0) * 2; rope8(v0, v1, *(const f32x4*)t, *(const f32x4*)(t + 4)); }
                    else if (pn == 15) { if (bj == 0 && wc < 2) { const float* t = T64 + ((size_t)pos * 32 + pi0) * 2; rope8(v0, v1, *(const f32x4*)t, *(const f32x4*)(t + 4)); } }
                    else if (pn >= 12) { sq += (v0[0] * v0[0] + v0[1] * v0[1]) + (v0[2] * v0[2] + v0[3] * v0[3]) + (v1[0] * v1[0] + v1[1] * v1[1]) + (v1[2] * v1[2] + v1[3] * v1[3]); }
                    if (pn != 15 || (bj == 0 && wc < 2)) {
                        u32x4 w; w.x = cvt_pk_bf16(v0[0], v0[1]); w.y = cvt_pk_bf16(v0[2], v0[3]); w.z = cvt_pk_bf16(v1[0], v1[1]); w.w = cvt_pk_bf16(v1[2], v1[3]);
                        __builtin_nontemporal_store(w, (u32x4*)(rowp + bj * HALF)); } }
                if (pn >= 12 && pn < 15) { sq += __shfl_xor(sq, 16); sq += __shfl_xor(sq, 32); if (fq == 0) ssq[(size_t)row * 12 + (pn - 12) * 4 + wc] = sq; }
                asm volatile("" ::: "memory"); }
    }
};
struct EpiMlaQ {
    static constexpr bool PERM = true, AFTER_DRAIN = false;
    bf16_t* O; int ldc; const float* T64; const float* ssq; int seq;
    __device__ __forceinline__ void operator()(const f32x4 (&acc)[2][2][4][2], const Unit& u, int wr, int wc, int fr, int fq) const {
        int row0 = u.pm * BM + wr * 64 + fr, col0 = u.pn * BM + wc * 32 + 8 * fq; asm volatile("" : "+v"(row0), "+v"(col0));
#pragma unroll
        for (int ai = 0; ai < 2; ++ai)
#pragma unroll
            for (int m = 0; m < 4; ++m) { const int row = row0 + ai * HALF + m * 16; bf16_t* rowp = O + (size_t)row * ldc + col0; const int pos = row & (seq - 1);
                const f32x4 s0 = *(const f32x4*)(ssq + (size_t)row * 12), s1 = *(const f32x4*)(ssq + (size_t)row * 12 + 4);
                const float rstd = 1.0f / sqrtf(((s0[0] + s0[1]) + (s0[2] + s0[3]) + (s1[0] + s1[1]) + (s1[2] + s1[3])) * (1.0f / 512.0f) + 1e-6f);
#pragma unroll
                for (int bj = 0; bj < 2; ++bj) { f32x4 v0 = acc[ai][bj][m][0] * rstd, v1 = acc[ai][bj][m][1] * rstd;
                    const int w0 = (col0 + bj * HALF) % 192;
                    if (w0 >= 128) { const float* t = T64 + ((size_t)pos * 32 + ((w0 - 128) >> 1)) * 2; rope8(v0, v1, *(const f32x4*)t, *(const f32x4*)(t + 4)); }
                    u32x4 w; w.x = cvt_pk_bf16(v0[0], v0[1]); w.y = cvt_pk_bf16(v0[2], v0[3]); w.z = cvt_pk_bf16(v1[0], v1[1]); w.w = cvt_pk_bf16(v1[2], v1[3]);
                    __builtin_nontemporal_store(w, (u32x4*)(rowp + bj * HALF)); }
                asm volatile("" ::: "memory"); }
    }
};
struct EpiMlaKV {
    static constexpr bool PERM = true, AFTER_DRAIN = false;
    bf16_t* O; int ldc; const float* ssq;
    __device__ __forceinline__ void operator()(const f32x4 (&acc)[2][2][4][2], const Unit& u, int wr, int wc, int fr, int fq) const {
        int row0 = u.pm * BM + wr * 64 + fr, col0 = u.pn * BM + wc * 32 + 8 * fq; asm volatile("" : "+v"(row0), "+v"(col0));
#pragma unroll
        for (int ai = 0; ai < 2; ++ai)
#pragma unroll
            for (int m = 0; m < 4; ++m) { const int row = row0 + ai * HALF + m * 16; bf16_t* rowp = O + (size_t)row * ldc + col0;
                const f32x4 s0 = *(const f32x4*)(ssq + (size_t)row * 12 + 8);
                const float rstd = 1.0f / sqrtf(((s0[0] + s0[1]) + (s0[2] + s0[3])) * (1.0f / 256.0f) + 1e-6f);
#pragma unroll
                for (int bj = 0; bj < 2; ++bj) { const f32x4 v0 = acc[ai][bj][m][0] * rstd, v1 = acc[ai][bj][m][1] * rstd;
                    u32x4 w; w.x = cvt_pk_bf16(v0[0], v0[1]); w.y = cvt_pk_bf16(v0[2], v0[3]); w.z = cvt_pk_bf16(v1[0], v1[1]); w.w = cvt_pk_bf16(v1[2], v1[3]);
                    __builtin_nontemporal_store(w, (u32x4*)(rowp + bj * HALF)); }
                asm volatile("" ::: "memory"); }
    }
};

template <class Epi, class Sched, bool ALIGN_EPI = false, bool SP2 = false, bool FP8 = false>
__device__ __forceinline__ void gemm_phase(PG8_LAS unsigned char* lds, const Gemm g, const Sched& S, const Epi& E) {
    int tid_ = threadIdx.x; asm volatile("" : "+v"(tid_));
    const int tid = tid_, wid = __builtin_amdgcn_readfirstlane(tid >> 6), lane = tid & 63, wr = wid >> 2, wc = wid & 3, fr = lane & 15, fq = lane >> 4;
    int K = g.K; asm volatile("" : "+s"(K)); const int nt = K / BK;
    unsigned voffA[2], voffB[2];
#pragma unroll
    for (int i = 0; i < 2; ++i) { int R, C; stage_rc(tid * 16 + i * 8192, R, C); const int Rb = Epi::PERM ? ((R & ~31) + perm32(R & 31)) : R;
        voffA[i] = (unsigned)(R * g.lda + C) * 2u; voffB[i] = (unsigned)(Rb * g.ldb + C) * 2u; }
    const size_t kstep = (size_t)(BK * 2);
    const size_t hstepA = (size_t)HALF * g.lda * 2, hstepB = (size_t)HALF * g.ldb * 2;
    const size_t tstepA = 2 * hstepA, tstepB = 2 * hstepB; const size_t apnb = (size_t)g.apn * 2, bpmb = (size_t)g.bpm * 2;
    const unsigned ldsw = (unsigned)wid * 1024u;
    const int aoff = lds_byte(wr * 64 + fr, fq * 8), boff = lds_byte(wc * 32 + fr, fq * 8);
#define PG8_SA(b, h) (((b) * 2 + (h)) * HTB)
#define PG8_SB(b, h) ((4 + (b) * 2 + (h)) * HTB)
#define PG8_STAGE(bufoff, gbase, voff) do { _Pragma("unroll") for (int _i = 0; _i < 2; ++_i) { unsigned vo_ = (voff)[_i]; asm volatile("" : "+v"(vo_));     \
        __builtin_amdgcn_global_load_lds((const unsigned*)((const char*)(gbase) + vo_), (PG8_LAS unsigned*)(lds + (bufoff) + ldsw + _i * 8192), 16, 0, 0); } } while (0)
#define PG8_LDA(dst, b, h) do { _Pragma("unroll") for (int m = 0; m < 4; ++m) { const pg8_i32x4 lo_ = *(const PG8_LAS pg8_i32x4*)(lds + PG8_SA(b, h) + aoff + m * 2048), hi_ = *(const PG8_LAS pg8_i32x4*)(lds + PG8_SA(b, h) + aoff + m * 2048 + 1024); dst[m] = __builtin_shufflevector(lo_, hi_, 0, 1, 2, 3, 4, 5, 6, 7); } } while (0)
#define PG8_LDB(dst, b, h) do { _Pragma("unroll") for (int n = 0; n < 2; ++n) { const pg8_i32x4 lo_ = *(const PG8_LAS pg8_i32x4*)(lds + PG8_SB(b, h) + boff + n * 2048), hi_ = *(const PG8_LAS pg8_i32x4*)(lds + PG8_SB(b, h) + boff + n * 2048 + 1024); dst[n] = __builtin_shufflevector(lo_, hi_, 0, 1, 2, 3, 4, 5, 6, 7); } } while (0)
#define PG8_MMA(ai, bj, At, Bt) do { __builtin_amdgcn_s_setprio(1); _Pragma("unroll") for (int m = 0; m < 4; ++m) _Pragma("unroll") for (int n = 0; n < 2; ++n) { \
        if constexpr (FP8) acc[ai][bj][m][n] = __builtin_amdgcn_mfma_scale_f32_16x16x128_f8f6f4(Bt[n], At[m], acc[ai][bj][m][n], 1, 0, 0, 0, 0, 0);     \
        else { const pg8_i32x8 bv_ = Bt[n], av_ = At[m];     \
               acc[ai][bj][m][n] = __builtin_amdgcn_mfma_f32_16x16x32_bf16(__builtin_bit_cast(bf16x8, __builtin_shufflevector(bv_, bv_, 0, 1, 2, 3)), __builtin_bit_cast(bf16x8, __builtin_shufflevector(av_, av_, 0, 1, 2, 3)), acc[ai][bj][m][n], 0, 0, 0); \
               acc[ai][bj][m][n] = __builtin_amdgcn_mfma_f32_16x16x32_bf16(__builtin_bit_cast(bf16x8, __builtin_shufflevector(bv_, bv_, 4, 5, 6, 7)), __builtin_bit_cast(bf16x8, __builtin_shufflevector(av_, av_, 4, 5, 6, 7)), acc[ai][bj][m][n], 0, 0, 0); } } \
        __builtin_amdgcn_s_setprio(0); } while (0)
#define PG8_WAIT_V(n) asm volatile("s_waitcnt vmcnt(" #n ")" ::: "memory")
#define PG8_WAIT_L(n) asm volatile("s_waitcnt lgkmcnt(" #n ")" ::: "memory")
#define PG8_BAR __builtin_amdgcn_s_barrier()
#define PG8_SCHED __builtin_amdgcn_sched_barrier(0)
    Unit cur, nxt; int ui = 0;
    if (!S.next(0, cur)) return;
    f32x4 acc[2][2][4][2];
    pg8_i32x8 At[4], B0[2], B1[2];
    const char* cA = (const char*)g.A + (size_t)cur.pm * tstepA + (size_t)cur.pn * apnb; const char* cB = (const char*)g.Bt + (size_t)cur.pn * tstepB + (size_t)cur.pm * bpmb;
    S.a_ready(cur);
    if constexpr (SP2) {
        PG8_STAGE(PG8_SB(0, 0), cB, voffB); PG8_STAGE(PG8_SB(0, 1), cB + hstepB, voffB); PG8_STAGE(PG8_SA(0, 0), cA, voffA); PG8_STAGE(PG8_SA(0, 1), cA + hstepA, voffA);
        if (wr == 1) PG8_BAR;
        PG8_WAIT_V(2); PG8_BAR;
        PG8_STAGE(PG8_SB(1, 0), cB + kstep, voffB); PG8_STAGE(PG8_SA(1, 0), cA + kstep, voffA); PG8_STAGE(PG8_SB(1, 1), cB + hstepB + kstep, voffB);
        PG8_WAIT_V(6); PG8_BAR;
    } else {
        PG8_STAGE(PG8_SB(0, 0), cB, voffB); PG8_STAGE(PG8_SA(0, 0), cA, voffA); PG8_STAGE(PG8_SB(0, 1), cB + hstepB, voffB); PG8_STAGE(PG8_SA(0, 1), cA + hstepA, voffA);
        if (wr == 1) PG8_BAR;
        PG8_WAIT_V(4); PG8_BAR;
        PG8_STAGE(PG8_SB(1, 0), cB + kstep, voffB); PG8_STAGE(PG8_SA(1, 0), cA + kstep, voffA); PG8_STAGE(PG8_SB(1, 1), cB + hstepB + kstep, voffB);
        PG8_WAIT_V(6); PG8_BAR;
    }
    __builtin_amdgcn_sched_barrier(0);
#pragma unroll
    for (int a = 0; a < 2; ++a)
#pragma unroll
        for (int b = 0; b < 2; ++b)
#pragma unroll
            for (int m = 0; m < 4; ++m)
#pragma unroll
                for (int n = 0; n < 2; ++n) acc[a][b][m][n] = (f32x4){0.f, 0.f, 0.f, 0.f};
    __builtin_amdgcn_sched_barrier(0);
    for (;;) {
        const bool has_next = S.next(ui + 1, nxt);
        const char* nA = has_next ? (const char*)g.A + (size_t)nxt.pm * tstepA + (size_t)nxt.pn * apnb : cA; const char* nB = has_next ? (const char*)g.Bt + (size_t)nxt.pn * tstepB + (size_t)nxt.pm * bpmb : cB;
        for (int t = 0; t < nt; t += 2) {
            const bool last = (t == nt - 2);
            const char* a1 = cA + (size_t)(t + 1) * kstep;
            const char* a2 = last ? nA : cA + (size_t)(t + 2) * kstep; const char* b2 = last ? nB : cB + (size_t)(t + 2) * kstep;
            const char* a3 = a2 + kstep; const char* b3 = b2 + kstep;
            if (last && has_next) S.a_ready(nxt);
            if constexpr (SP2) {
            PG8_LDB(B0, 0, 0); PG8_LDB(B1, 0, 1); PG8_SCHED; PG8_LDA(At, 0, 0); PG8_STAGE(PG8_SA(1, 1), a1 + hstepA, voffA);
            PG8_WAIT_V(8); PG8_WAIT_L(0); PG8_BAR; PG8_MMA(0, 0, At, B0); PG8_MMA(0, 1, At, B1); PG8_BAR; PG8_SCHED;
            PG8_LDA(At, 0, 1); PG8_STAGE(PG8_SB(0, 0), b2, voffB); PG8_STAGE(PG8_SB(0, 1), b2 + hstepB, voffB); PG8_STAGE(PG8_SA(0, 0), a2, voffA);
            PG8_WAIT_V(8); PG8_WAIT_L(0); PG8_BAR; PG8_MMA(1, 0, At, B0); PG8_MMA(1, 1, At, B1); PG8_BAR; PG8_SCHED;
            PG8_LDB(B0, 1, 0); PG8_LDB(B1, 1, 1); PG8_SCHED; PG8_LDA(At, 1, 0); PG8_STAGE(PG8_SA(0, 1), a2 + hstepA, voffA);
            PG8_WAIT_V(8); PG8_WAIT_L(0); PG8_BAR; PG8_MMA(0, 0, At, B0); PG8_MMA(0, 1, At, B1); PG8_BAR; PG8_SCHED;
            PG8_LDA(At, 1, 1); PG8_STAGE(PG8_SB(1, 0), b3, voffB); PG8_STAGE(PG8_SB(1, 1), b3 + hstepB, voffB); PG8_STAGE(PG8_SA(1, 0), a3, voffA);
            PG8_WAIT_V(8); PG8_WAIT_L(0); PG8_BAR; PG8_MMA(1, 0, At, B0); PG8_MMA(1, 1, At, B1); PG8_BAR; PG8_SCHED;
            } else {
            PG8_LDB(B0, 0, 0); PG8_SCHED; PG8_LDA(At, 0, 0); PG8_STAGE(PG8_SA(1, 1), a1 + hstepA, voffA);
            PG8_WAIT_L(8); PG8_BAR; PG8_WAIT_L(0); PG8_MMA(0, 0, At, B0); PG8_BAR; PG8_SCHED;
            PG8_LDB(B1, 0, 1); PG8_STAGE(PG8_SB(0, 0), b2, voffB);
            PG8_BAR; PG8_WAIT_L(0); PG8_MMA(0, 1, At, B1); PG8_BAR;
            PG8_LDA(At, 0, 1); PG8_STAGE(PG8_SA(0, 0), a2, voffA);
            PG8_BAR; PG8_WAIT_L(0); PG8_MMA(1, 0, At, B0); PG8_BAR; PG8_SCHED;
            PG8_STAGE(PG8_SB(0, 1), b2 + hstepB, voffB);
            PG8_WAIT_V(6); PG8_BAR; PG8_MMA(1, 1, At, B1); PG8_BAR;
            PG8_LDB(B0, 1, 0); PG8_SCHED; PG8_LDA(At, 1, 0); PG8_STAGE(PG8_SA(0, 1), a2 + hstepA, voffA);
            PG8_WAIT_L(8); PG8_BAR; PG8_WAIT_L(0); PG8_MMA(0, 0, At, B0); PG8_BAR; PG8_SCHED;
            PG8_LDB(B1, 1, 1); PG8_STAGE(PG8_SB(1, 0), b3, voffB);
            PG8_BAR; PG8_WAIT_L(0); PG8_MMA(0, 1, At, B1); PG8_BAR;
            PG8_LDA(At, 1, 1); PG8_STAGE(PG8_SA(1, 0), a3, voffA);
            PG8_BAR; PG8_WAIT_L(0); PG8_MMA(1, 0, At, B0); PG8_BAR; PG8_SCHED;
            PG8_STAGE(PG8_SB(1, 1), b3 + hstepB, voffB);
            PG8_WAIT_V(6); PG8_BAR; PG8_MMA(1, 1, At, B1); PG8_BAR;
            }
        }
        if constexpr (ALIGN_EPI) { if (wr == 0) PG8_BAR; }
        if constexpr (!Epi::AFTER_DRAIN) { E(acc, cur, wr, wc, fr, fq); S.done(cur); }
        if (!has_next) break;
#pragma unroll
        for (int a = 0; a < 2; ++a)
#pragma unroll
            for (int b = 0; b < 2; ++b)
#pragma unroll
                for (int m = 0; m < 4; ++m)
#pragma unroll
                    for (int n = 0; n < 2; ++n) acc[a][b][m][n] = (f32x4){0.f, 0.f, 0.f, 0.f};
        cur = nxt; cA = nA; cB = nB; ++ui;
        if constexpr (ALIGN_EPI) { if (wr == 1) PG8_BAR; }
    }
    PG8_WAIT_V(0);
    if constexpr (!ALIGN_EPI) { if (wr == 0) PG8_BAR; }
    PG8_BAR;
    if constexpr (Epi::AFTER_DRAIN) { E.fused(acc, cur, wr, wc, fr, fq, lds, wid, lane); S.done(cur); }
#undef PG8_SA
#undef PG8_SB
#undef PG8_STAGE
#undef PG8_LDA
#undef PG8_LDB
#undef PG8_MMA
#undef PG8_WAIT_V
#undef PG8_WAIT_L
#undef PG8_BAR
#undef PG8_SCHED
}
}

constexpr int NWAVES = 8, NTHREADS = NWAVES * 64;
constexpr int BATCH = 2, SEQ = 8192, DM = 2048, MTOK = BATCH * SEQ;
constexpr int EVEN_IN = 3904, EVEN_INP = 4096, ODD_IN = 6144;
constexpr int NEXP = 16384;
constexpr float LN_EPS = 1e-5f;
constexpr float DN_ALPHA = 1.4142135623730951f;
constexpr float LOG2E = 1.4426950408889634f;

constexpr size_t MiB = 1u << 20;
constexpr size_t WS_CTL = 0, CTL_ZERO_BYTES = 1 * MiB;
constexpr size_t WS_WIN0 = 2 * MiB, WS_WQB = 18 * MiB, WS_WKVB = 20 * MiB, WS_WOUT0 = 22 * MiB, WS_WIN1 = 30 * MiB, WS_WOUT1 = 54 * MiB, WS_WPQ = 62 * MiB  , WS_KB = 78 * MiB  ;
constexpr size_t WS_T128 = 80 * MiB, WS_T64 = 84 * MiB, WS_SSQ = 86 * MiB, WS_IDX = 88 * MiB, WS_G = 96 * MiB;
constexpr size_t WS_QS = 87 * MiB;
constexpr size_t WS_UV = 104 * MiB;
constexpr size_t WS_XB = 360 * MiB;
constexpr size_t WS_XF = 424 * MiB;
constexpr size_t WS_A = 552 * MiB;
constexpr size_t WS_B = 744 * MiB;
constexpr size_t WS_C = 872 * MiB;
constexpr size_t WS_WS = 936 * MiB;
constexpr size_t WS_W8IN1 = 952 * MiB;
constexpr size_t WS_X8 = 968 * MiB;
constexpr size_t WS_END = 1000 * MiB;
constexpr int CW_BAR = 4096;

constexpr int RING_BYTES = 147456;
constexpr int MISC_OFF = RING_BYTES;
constexpr int LDS_BYTES = 151552;

#define GAS __attribute__((address_space(1)))
#define LAS __attribute__((address_space(3)))
#define DI __device__ __forceinline__
typedef unsigned short bf16;
typedef unsigned u32x4 __attribute__((ext_vector_type(4)));
typedef unsigned u32x2 __attribute__((ext_vector_type(2)));
typedef float f32x4 __attribute__((ext_vector_type(4)));
typedef float f32x2 __attribute__((ext_vector_type(2)));
typedef float f32x16 __attribute__((ext_vector_type(16)));
typedef short bf16x8 __attribute__((ext_vector_type(8)));
typedef short s16x4 __attribute__((ext_vector_type(4)));
typedef __bf16 bfx2 __attribute__((ext_vector_type(2)));
#define LDS_WAIT() asm volatile("s_waitcnt lgkmcnt(0)" ::: "memory")

DI unsigned f2bf(float f) { unsigned u = __builtin_bit_cast(unsigned, f); return (u + 0x7fffu + ((u >> 16) & 1u)) >> 16; }
DI unsigned pk2(float lo, float hi) { return f2bf(lo) | (f2bf(hi) << 16); }
DI unsigned cvtpk(float lo, float hi) { f32x2 v = {lo, hi}; bfx2 b = __builtin_convertvector(v, bfx2); return __builtin_bit_cast(unsigned, b); }
DI float bflo(unsigned w) { return __builtin_bit_cast(float, w << 16); }
DI float bfhi(unsigned w) { return __builtin_bit_cast(float, w & 0xffff0000u); }

template <int CTRL> DI int dpp_i(int v) { return __builtin_amdgcn_update_dpp(v, v, CTRL, 0xF, 0xF, true); }
DI float wave_sum(float v) {
    v += __builtin_bit_cast(float, dpp_i<0xB1>(__builtin_bit_cast(int, v)));
    v += __builtin_bit_cast(float, dpp_i<0x4E>(__builtin_bit_cast(int, v)));
    v += __builtin_bit_cast(float, dpp_i<0x141>(__builtin_bit_cast(int, v)));
    v += __builtin_bit_cast(float, dpp_i<0x140>(__builtin_bit_cast(int, v)));
    const int i = __builtin_bit_cast(int, v);
    return (__builtin_bit_cast(float, __builtin_amdgcn_readlane(i, 0)) + __builtin_bit_cast(float, __builtin_amdgcn_readlane(i, 16))) +
           (__builtin_bit_cast(float, __builtin_amdgcn_readlane(i, 32)) + __builtin_bit_cast(float, __builtin_amdgcn_readlane(i, 48)));
}
DI unsigned umax2(unsigned a, unsigned b) { return a > b ? a : b; }
DI unsigned wave_umax(unsigned v) {
    v = umax2(v, (unsigned)dpp_i<0xB1>((int)v));
    v = umax2(v, (unsigned)dpp_i<0x4E>((int)v));
    v = umax2(v, (unsigned)dpp_i<0x141>((int)v));
    v = umax2(v, (unsigned)dpp_i<0x140>((int)v));
    const unsigned a = (unsigned)__builtin_amdgcn_readlane((int)v, 0), b = (unsigned)__builtin_amdgcn_readlane((int)v, 16);
    const unsigned c = (unsigned)__builtin_amdgcn_readlane((int)v, 32), d = (unsigned)__builtin_amdgcn_readlane((int)v, 48);
    return umax2(umax2(a, b), umax2(c, d));
}
DI float rdlane_f(float v, int l) { return __builtin_bit_cast(float, __builtin_amdgcn_readlane(__builtin_bit_cast(int, v), l)); }
DI void xhalf(float x, float& lo, float& hi) { const unsigned u = __builtin_bit_cast(unsigned, x); const auto r = __builtin_amdgcn_permlane32_swap(u, u, false, false); const unsigned r0 = (unsigned)r[0], r1 = (unsigned)r[1];     lo = __builtin_bit_cast(float, r0); hi = __builtin_bit_cast(float, r1); }

#define XB_TMO      128
#define XB_XCNT(j)  (256  + 64 * (j))
#define XB_XSUB(j)  (1280 + 64 * (j))
#define XB_XGEN(j)  (2304 + 64 * (j))
#define XB_TOP      3328
#define XB_TOPGEN   3392
#define XCD_BAR_WORDS 3456
#define XB_SPIN_CAP (1u << 18)

__device__ __forceinline__ unsigned xb_ld(unsigned* p)              { return __hip_atomic_load(p, __ATOMIC_RELAXED, __HIP_MEMORY_SCOPE_AGENT); }
__device__ __forceinline__ unsigned xb_add(unsigned* p, unsigned v) { return __hip_atomic_fetch_add(p, v, __ATOMIC_RELAXED, __HIP_MEMORY_SCOPE_AGENT); }
__device__ __forceinline__ unsigned xb_xcc_id() { return (unsigned)__builtin_amdgcn_s_getreg((3 << 11) | 20) & 0xFu; }
#define XB_SPIN(cond, bar) do { unsigned _sp = 0; while (cond) { __builtin_amdgcn_s_sleep(1); \
    if ((++_sp & 255u) == 0u) { if (xb_ld(&(bar)[XB_TMO])) break; if (_sp > XB_SPIN_CAP) { atomicAdd(&(bar)[XB_TMO], 1u); break; } } } } while (0)

struct XcdBarrier {
    unsigned* bar; unsigned x;
    volatile LAS unsigned* st;
};

__device__ __forceinline__ XcdBarrier xcd_barrier_post(unsigned* bar, volatile LAS unsigned* st) {
    XcdBarrier b; b.bar = bar; b.x = xb_xcc_id(); b.st = st;
    if (threadIdx.x == 0) (void)xb_add(&bar[XB_XCNT(b.x)], 1u);
    return b;
}
__device__ __forceinline__ void xcd_barrier_complete(unsigned* bar, unsigned x, unsigned& nloc, unsigned& nx) {
    const unsigned G = gridDim.x * gridDim.y * gridDim.z;
    unsigned sum, cnt, mine, sp = 0u;
    for (;;) {
        sum = 0u; cnt = 0u; mine = 0u;
#pragma unroll
        for (unsigned j = 0; j < 16; ++j) { const unsigned c = xb_ld(&bar[XB_XCNT(j)]); sum += c; cnt += (c > 0u) ? 1u : 0u; mine = (j == x) ? c : mine; }
        if (sum == G) break;
        __builtin_amdgcn_s_sleep(1);
        if ((++sp & 255u) == 0u) { if (xb_ld(&bar[XB_TMO])) break; if (sp > XB_SPIN_CAP) { atomicAdd(&bar[XB_TMO], 1u); break; } }
    }
    nloc = mine > 0u ? mine : 1u; nx = cnt > 0u ? cnt : 1u;
}

__device__ __forceinline__ void xcd_barrier(const XcdBarrier& b) {
    asm volatile("s_waitcnt vmcnt(0)" ::: "memory");
    __syncthreads();
    if (threadIdx.x == 0) {
        unsigned* bar = b.bar;
        __builtin_amdgcn_s_waitcnt(0);
        unsigned nloc = b.st[0], nx = b.st[1];
        if (nloc == 0u) { xcd_barrier_complete(bar, b.x, nloc, nx); b.st[0] = nloc; b.st[1] = nx; }
        const unsigned old = xb_add(&bar[XB_XSUB(b.x)], 1u);
        const unsigned gen = old / nloc;
        if (old + 1u == (gen + 1u) * nloc) {
            __builtin_amdgcn_fence(__ATOMIC_RELEASE, "agent");
            asm volatile("s_waitcnt vmcnt(0)" ::: "memory");
            const unsigned og = xb_add(&bar[XB_TOP], 1u);
            const unsigned tg = og / nx;
            if (og + 1u == (tg + 1u) * nx) xb_add(&bar[XB_TOPGEN], 1u);
            else XB_SPIN(xb_ld(&bar[XB_TOPGEN]) == tg, bar);
            __builtin_amdgcn_fence(__ATOMIC_ACQUIRE, "agent");
            xb_add(&bar[XB_XGEN(b.x)], 1u);
            asm volatile("s_waitcnt vmcnt(0)" ::: "memory");
        } else {
            XB_SPIN(xb_ld(&bar[XB_XGEN(b.x)]) == gen, bar);
            __builtin_amdgcn_fence(__ATOMIC_ACQUIRE, "agent");
            asm volatile("s_waitcnt vmcnt(0)" ::: "memory");
        }
    }
    __syncthreads();
}

template <int MAP> DI int dest_row(int n) {
    if (MAP == 1) {
        if (n < 2048) { const int hh = n >> 7, w = n & 127; return hh * 128 + 2 * (w & 63) + (w >> 6); }
        if (n >= 3840) { const int j = n - 3840; return 3840 + 2 * (j & 31) + (j >> 5); }
        return n;
    }
    if (MAP == 2) { const int hh = n / 192, w = n - hh * 192; if (w < 128) return n; const int j = w - 128; return hh * 192 + 128 + 2 * (j & 31) + (j >> 5); }
    return n;
}
template <int MAP> DI void transpose_item(const float* __restrict__ W, int K, int N, bf16* WT, const float* __restrict__ gain, LAS float* scr, int item, int lane) {
    const int nblk = N / 32, kb = item / nblk, nb = item % nblk, k0 = 64 * kb, n0 = 32 * nb;
    float tv[32];
#pragma unroll
    for (int i = 0; i < 32; ++i) { const int kk = 2 * i + (lane >> 5); tv[i] = W[(size_t)(k0 + kk) * N + n0 + (lane & 31)]; }
    if (gain) {
#pragma unroll
        for (int i = 0; i < 32; ++i) tv[i] *= gain[k0 + 2 * i + (lane >> 5)]; }
#pragma unroll
    for (int i = 0; i < 32; ++i) { const int kk = 2 * i + (lane >> 5); scr[kk * 33 + (lane & 31)] = tv[i]; }
    LDS_WAIT();
    const int c = lane & 7;
#pragma unroll
    for (int j = 0; j < 4; ++j) { const int n = (lane >> 3) + 8 * j; const LAS float* s = scr + (8 * c) * 33 + n;
        u32x4 o; o.x = pk2(s[0 * 33], s[1 * 33]); o.y = pk2(s[2 * 33], s[3 * 33]); o.z = pk2(s[4 * 33], s[5 * 33]); o.w = pk2(s[6 * 33], s[7 * 33]);
        *(u32x4*)(WT + (size_t)dest_row<MAP>(n0 + n) * K + k0 + 8 * c) = o; }
    LDS_WAIT();
}
template <int MAP> DI void transpose_item_fp8(const float* __restrict__ W, int K, int N, unsigned char* WT, float mul, LAS float* scr, int item, int lane) {
    const int nblk = N / 64, kb = item / nblk, nb = item % nblk, k0 = 64 * kb, n0 = 64 * nb;
    f32x4 tv[16];
#pragma unroll
    for (int i = 0; i < 16; ++i) tv[i] = __builtin_nontemporal_load((const f32x4*)(W + (size_t)(k0 + 4 * i + (lane >> 4)) * N + n0 + 4 * (lane & 15)));
#pragma unroll
    for (int i = 0; i < 16; ++i) *(LAS f32x4*)(scr + (4 * i + (lane >> 4)) * 68 + 4 * (lane & 15)) = tv[i] * mul;
    LDS_WAIT();
    const LAS float* sp = scr + lane;
    unsigned char* dst = WT + (size_t)dest_row<MAP>(n0 + lane) * K + k0;
#pragma unroll
    for (int q4 = 0; q4 < 4; ++q4) { unsigned ow[4];
#pragma unroll
        for (int q = 0; q < 4; ++q) { const LAS float* p = sp + (16 * q4 + 4 * q) * 68;
            int w = 0; w = __builtin_amdgcn_cvt_pk_bf8_f32(p[0 * 68], p[1 * 68], w, false); w = __builtin_amdgcn_cvt_pk_bf8_f32(p[2 * 68], p[3 * 68], w, true); ow[q] = (unsigned)w; }
        *(u32x4*)(dst + 16 * q4) = (u32x4){ow[0], ow[1], ow[2], ow[3]}; }
    LDS_WAIT();
}
DI void convert_flat(const float* __restrict__ src, bf16* dst, size_t n, int gw, int NGW, int lane) {
    const size_t nit = n / 512;
    for (size_t it = gw; it < nit; it += (size_t)4 * NGW) {
        f32x4 a[4], b[4]; size_t e[4];
#pragma unroll
        for (int u = 0; u < 4; ++u) { size_t iu = it + (size_t)u * NGW; if (iu >= nit) iu = it; e[u] = iu * 512 + (size_t)lane * 8; a[u] = *(const f32x4*)(src + e[u]); b[u] = *(const f32x4*)(src + e[u] + 4); }
#pragma unroll
        for (int u = 0; u < 4; ++u) { u32x4 o; o.x = pk2(a[u][0], a[u][1]); o.y = pk2(a[u][2], a[u][3]); o.z = pk2(b[u][0], b[u][1]); o.w = pk2(b[u][2], b[u][3]);
            *(u32x4*)(dst + e[u]) = o; }
    }
}
DI unsigned fp6_code(float v) {
    const float a = fminf(fabsf(v), 7.5f);
    const int e = a >= 4.f ? 2 : (a >= 2.f ? 1 : 0);
    const float sc = e == 2 ? 2.f : (e == 1 ? 4.f : 8.f);
    int code = 8 * e + (int)rintf(a * sc); code = code > 31 ? 31 : code;
    return (v < 0.f ? 32u : 0u) | (unsigned)code;
}
DI unsigned fp4_code(float v) {
    const float a = fabsf(v);
    const unsigned c = (a > 0.25f) + (a > 0.75f) + (a > 1.25f) + (a > 1.75f) + (a > 2.5f) + (a > 3.5f) + (a > 5.0f);
    return (v < 0.f ? 8u : 0u) | c;
}
#ifndef U_FP4
#define U_FP4 1
#endif
#ifndef FP4_HI_FIRST
#define FP4_HI_FIRST 0
#endif
struct ProArgs {
    const float *x, *a_w_in, *b_q_norm, *b_w_q_b, *b_kv_norm, *b_w_kv_b, *ab_w_out, *c_w_in, *c_w_out, *peer_w_query, *peer_sub_keys, *peer_u, *peer_v;
    unsigned char* ws;
};
DI void prologue(const ProArgs& a, LAS unsigned char* lds, int gw, int NGW, int wave, int lane_in) {
    int lane = lane_in; asm volatile("" : "+v"(lane));
    LAS float* scr = (LAS float*)(lds + wave * 17408);
    unsigned char* ws = a.ws;
    constexpr int I_IN0 = (DM / 64) * (EVEN_IN / 64), I_QB = (512 / 64) * (1536 / 32), I_KVB = (256 / 64) * (2048 / 32), I_SQ = (DM / 64) * (DM / 64), I_IN1 = (DM / 64) * (ODD_IN / 64);
    constexpr int NITEMS = I_IN0 + I_QB + I_KVB + I_SQ + I_IN1 + I_SQ;
    for (int it = gw; it < NITEMS; it += NGW) {
        int r = it;
        if (r < I_IN0) { transpose_item_fp8<1>(a.a_w_in, DM, EVEN_IN, ws + WS_WIN0, 1.0f, scr, r, lane); continue; } r -= I_IN0;
        if (r < I_QB) { transpose_item<2>(a.b_w_q_b, 512, 1536, (bf16*)(ws + WS_WQB), a.b_q_norm, scr, r, lane); continue; } r -= I_QB;
        if (r < I_KVB) { transpose_item<0>(a.b_w_kv_b, 256, 2048, (bf16*)(ws + WS_WKVB), a.b_kv_norm, scr, r, lane); continue; } r -= I_KVB;
        if (r < I_SQ) { transpose_item_fp8<0>(a.ab_w_out, DM, DM, ws + WS_WOUT0, 1.0f, scr, r, lane); continue; } r -= I_SQ;
        if (r < I_IN1) { transpose_item_fp8<0>(a.c_w_in, DM, ODD_IN, ws + WS_W8IN1, 1.0f, scr, r, lane); continue; } r -= I_IN1;
        transpose_item_fp8<0>(a.c_w_out, DM, DM, ws + WS_WOUT1, 1.0f, scr, r, lane);
    }
    convert_flat(a.peer_w_query, (bf16*)(ws + WS_WPQ), (size_t)2 * DM * DM, gw, NGW, lane);
    { unsigned char* wz = ws + WS_WIN0 + (size_t)EVEN_IN * DM; const size_t nz = (size_t)(EVEN_INP - EVEN_IN) * DM / 16;
      for (size_t i = (size_t)gw * 64 + lane; i < nz; i += (size_t)NGW * 64) *(u32x4*)(wz + i * 16) = (u32x4){0u, 0u, 0u, 0u}; }
    { bf16* kb = (bf16*)(ws + WS_KB);
      for (size_t i = (size_t)gw * 64 + lane; i < (size_t)2 * 2048 * 256 / 8; i += (size_t)NGW * 64) {
          const size_t e = i * 8; const int layer = (int)(e / (2048 * 256)); const int rem = (int)(e % (2048 * 256)); const int n = rem >> 8, k = rem & 255;
          const int h = n >> 8, p = (n >> 7) & 1, nn = n & 127, pp = k >> 7, kk = k & 127;
          u32x4 o = (u32x4){0u, 0u, 0u, 0u};
          if (p == pp) { const float* s = a.peer_sub_keys + ((((size_t)layer * 8 + h) * 2 + p) * 128 + nn) * 128 + kk; const f32x4 u = *(const f32x4*)s, v = *(const f32x4*)(s + 4);
              o.x = pk2(u[0], u[1]); o.y = pk2(u[2], u[3]); o.z = pk2(v[0], v[1]); o.w = pk2(v[2], v[3]); }
          *(u32x4*)(kb + e) = o; } }
    { float* t128 = (float*)(ws + WS_T128); float* t64 = (float*)(ws + WS_T64);
      for (int i = gw * 64 + lane; i < SEQ * 96; i += NGW * 64) {
          const int pos = i / 96, j = i % 96; const bool big = j < 64; const int idx = big ? j : j - 64; const float half = big ? 64.f : 32.f;
          const float inv = powf(10000.0f, -(float)idx / half); const float ang = (float)pos * inv;
          const float c = cosf(ang), s = sinf(ang);
          float* d = big ? t128 + ((size_t)pos * 64 + idx) * 2 : t64 + ((size_t)pos * 32 + idx) * 2; d[0] = c; d[1] = s; } }
    {
#define QLOAD(dst, r_) do { const int tb_ = (r_) / NEXP, er_ = (r_) % NEXP; const float* src_ = ((tb_ & 1) ? a.peer_v : a.peer_u) + ((size_t)(tb_ >> 1) * NEXP + er_) * DM + 4 * lane; \
          _Pragma("unroll") for (int qq_ = 0; qq_ < 8; ++qq_) (dst)[qq_] = __builtin_nontemporal_load((const f32x4*)(src_ + 256 * qq_)); } while (0)
      int row = gw; f32x4 v[8], vn[8];
      if (row < 4 * NEXP) QLOAD(v, row);
      while (row < 4 * NEXP) {
          const int nrow = row + NGW;
          if (nrow < 4 * NEXP) QLOAD(vn, nrow);
          float am = 0.f;
#pragma unroll
          for (int qq = 0; qq < 8; ++qq) am = fmaxf(am, fmaxf(fmaxf(fabsf(v[qq][0]), fabsf(v[qq][1])), fmaxf(fabsf(v[qq][2]), fabsf(v[qq][3]))));
          const float amax = __builtin_bit_cast(float, wave_umax(__builtin_bit_cast(unsigned, am)));
          const bool isv = U_FP4 ? true : ((row / NEXP) & 1) != 0;
          const float top = isv ? 6.0f : 7.5f;
          const float inv = amax > 0.f ? top / amax : 1.0f;
          if (lane == 0) ((float*)(ws + WS_QS))[row] = amax > 0.f ? amax / top : 1.0f;
          if (isv) {
              unsigned wq[4] = {0u, 0u, 0u, 0u};
#pragma unroll
              for (int d = 0; d < 4; ++d) {
                  unsigned w = 0u; const f32x4 lo = v[2 * d] * inv, hi = v[2 * d + 1] * inv;
                  w = __builtin_amdgcn_cvt_scalef32_pk_fp4_f32(w, lo[0], lo[1], 1.0f, 0); w = __builtin_amdgcn_cvt_scalef32_pk_fp4_f32(w, lo[2], lo[3], 1.0f, 1);
                  w = __builtin_amdgcn_cvt_scalef32_pk_fp4_f32(w, hi[0], hi[1], 1.0f, 2); w = __builtin_amdgcn_cvt_scalef32_pk_fp4_f32(w, hi[2], hi[3], 1.0f, 3);
                  wq[d] = w; }
              unsigned char* dstv = ws + WS_UV + (size_t)(row / NEXP) * 24 * MiB + (size_t)(row % NEXP) * 1024;
              *(u32x4*)(dstv + 16 * lane) = (u32x4){wq[0], wq[1], wq[2], wq[3]};
          } else {
          unsigned long long w0 = 0ull, w1 = 0ull, w2 = 0ull;
#pragma unroll
          for (int j = 0; j < 32; ++j) { const unsigned long long cde = (unsigned long long)fp6_code(v[j >> 2][j & 3] * inv); const int pos = 6 * j;
              if (pos < 64) { w0 |= cde << pos; if (pos + 6 > 64) w1 |= cde >> (64 - pos); }
              else if (pos < 128) { w1 |= cde << (pos - 64); if (pos + 6 > 128) w2 |= cde >> (128 - pos); }
              else w2 |= cde << (pos - 128); }
          unsigned char* dst = ws + WS_UV + (size_t)row * 1536;
          *(u32x4*)(dst + 16 * lane) = (u32x4){(unsigned)w0, (unsigned)(w0 >> 32), (unsigned)w1, (unsigned)(w1 >> 32)};
          *(u32x2*)(dst + 1024 + 8 * lane) = (u32x2){(unsigned)w2, (unsigned)(w2 >> 32)};
          }
#pragma unroll
          for (int qq = 0; qq < 8; ++qq) v[qq] = vn[qq];
          row = nrow;
      }
#undef QLOAD
    }
    { const size_t nit = (size_t)MTOK * DM / 512; bf16* dstb = (bf16*)(ws + WS_XB); unsigned char* dst8 = ws + WS_X8;
      for (size_t it = gw; it < nit; it += (size_t)8 * NGW) {
          f32x4 p[8], q[8]; size_t e[8];
#pragma unroll
          for (int u = 0; u < 8; ++u) { size_t iu = it + (size_t)u * NGW; if (iu >= nit) iu = it; e[u] = iu * 512 + (size_t)lane * 8; p[u] = __builtin_nontemporal_load((const f32x4*)(a.x + e[u])); q[u] = __builtin_nontemporal_load((const f32x4*)(a.x + e[u] + 4)); }
#pragma unroll
          for (int u = 0; u < 8; ++u) {
              u32x4 o; o.x = pk2(p[u][0], p[u][1]); o.y = pk2(p[u][2], p[u][3]); o.z = pk2(q[u][0], q[u][1]); o.w = pk2(q[u][2], q[u][3]);
              *(u32x4*)(dstb + e[u]) = o;
              int w0 = 0, w1 = 0; w0 = __builtin_amdgcn_cvt_pk_fp8_f32(p[u][0], p[u][1], w0, false); w0 = __builtin_amdgcn_cvt_pk_fp8_f32(p[u][2], p[u][3], w0, true);
              w1 = __builtin_amdgcn_cvt_pk_fp8_f32(q[u][0], q[u][1], w1, false); w1 = __builtin_amdgcn_cvt_pk_fp8_f32(q[u][2], q[u][3], w1, true);
              *(u32x2*)(dst8 + e[u]) = (u32x2){(unsigned)w0, (unsigned)w1}; } } }
}


namespace att {
#define MFMA32(a, b, c) __builtin_amdgcn_mfma_f32_32x32x16_bf16((a), (b), (c), 0, 0, 0)
typedef short v4i16_t __attribute__((ext_vector_type(4)));
DI int crow(int i, int hh) { return (i & 3) + 8 * (i >> 2) + 4 * hh; }
DI unsigned off_b(unsigned row, unsigned ch) { return 256u * row + 16u * (ch ^ (((row & 3u) << 2) | ((row >> 2) & 3u))); }
DI s16x4 vtr(LAS const unsigned char* p) { return __builtin_bit_cast(s16x4, __builtin_amdgcn_ds_read_tr16_b64_v4i16((LAS v4i16_t*)p)); }

constexpr int QK_DEPTH = 6, PV_DEPTH = 4;
template <int NS, int NBLK, int KP, int DEPTH = QK_DEPTH>
DI void qk_tile(f32x16 (&x)[NBLK], const bf16x8 (&qf)[NS], LAS const unsigned char* kimg, int r, int hh) {
    constexpr int N = NS * NBLK, D = N < DEPTH ? N : DEPTH;
    bf16x8 a[N];
#pragma unroll
    for (int i = 0; i < N; ++i) { const int s = i / NBLK, b = i % NBLK;
        const unsigned o = KP ? (unsigned)((32 * b + r) * KP + (2 * s + hh) * 16) : off_b((unsigned)(32 * b + r), (unsigned)(2 * s + hh));
        a[i] = *(LAS const bf16x8*)(kimg + o); }
#pragma unroll
    for (int b = 0; b < NBLK; ++b)
#pragma unroll
        for (int i = 0; i < 16; ++i) x[b][i] = 0.f;
#pragma unroll
    for (int i = 0; i < N; ++i) { const int s = i / NBLK, b = i % NBLK; x[b] = MFMA32(a[i], qf[s], x[b]); }
    __builtin_amdgcn_sched_group_barrier(0x100, D, 0);
#pragma unroll
    for (int i = 0; i < N - D; ++i) { __builtin_amdgcn_sched_group_barrier(0x008, 1, 0); __builtin_amdgcn_sched_group_barrier(0x100, 1, 0); }
    __builtin_amdgcn_sched_group_barrier(0x008, D, 0);
}
template <int NBLK>
DI void pv_tile(f32x16 (&o)[4], const f32x16 (&p)[NBLK], LAS const unsigned char* vimg, int lane) {
    const unsigned hh = lane >> 5, blkL = (lane >> 4) & 1, q = (lane & 15) >> 2, pp = lane & 3;
    constexpr int N = NBLK * 8, D = PV_DEPTH;
    bf16x8 vf[N], pf[NBLK * 2];
#pragma unroll
    for (int b = 0; b < NBLK; ++b)
#pragma unroll
        for (int s2 = 0; s2 < 2; ++s2) {
            u32x4 pw;
            pw.x = cvtpk(p[b][8 * s2 + 0], p[b][8 * s2 + 1]); pw.y = cvtpk(p[b][8 * s2 + 2], p[b][8 * s2 + 3]);
            pw.z = cvtpk(p[b][8 * s2 + 4], p[b][8 * s2 + 5]); pw.w = cvtpk(p[b][8 * s2 + 6], p[b][8 * s2 + 7]);
            pf[2 * b + s2] = __builtin_bit_cast(bf16x8, pw);
            const unsigned R0 = 32u * b + 16u * s2 + 4u * hh;
#pragma unroll
            for (int c = 0; c < 4; ++c) {
                const unsigned ch = 4u * c + 2u * blkL + (pp >> 1);
                const s16x4 lo = vtr(vimg + off_b(R0 + q, ch) + 8u * (pp & 1));
                const s16x4 hi = vtr(vimg + off_b(R0 + 8u + q, ch) + 8u * (pp & 1));
                vf[(2 * b + s2) * 4 + c] = __builtin_shufflevector(lo, hi, 0, 1, 2, 3, 4, 5, 6, 7);
            }
        }
#pragma unroll
    for (int i = 0; i < N; ++i) o[i & 3] = MFMA32(vf[i], pf[i >> 2], o[i & 3]);
    __builtin_amdgcn_sched_group_barrier(0x100, 2 * D, 0);
#pragma unroll
    for (int i = 0; i < N - D; ++i) { __builtin_amdgcn_sched_group_barrier(0x008, 1, 0); __builtin_amdgcn_sched_group_barrier(0x100, 2, 0); }
    __builtin_amdgcn_sched_group_barrier(0x008, D, 0);
}
template <int NBLK, bool SEL, class Valid>
DI void softmax_step(f32x16 (&x)[NBLK], f32x16 (&o)[4], float& m, float& l, float sc, bool need_mask, const Valid& valid) {
    if (need_mask) {
#pragma unroll
        for (int b = 0; b < NBLK; ++b)
#pragma unroll
            for (int i = 0; i < 16; ++i) if (!valid(b, i)) x[b][i] = -1e30f;
    }
    float tmax = -1e30f;
#pragma unroll
    for (int b = 0; b < NBLK; ++b)
#pragma unroll
        for (int i = 0; i < 16; ++i) tmax = fmaxf(tmax, x[b][i]);
    { float tl_, th_; xhalf(tmax, tl_, th_); tmax = fmaxf(tl_, th_); }
    const bool keep = __all((tmax - m) * sc <= 8.0f);
    if (!keep) {
        const float mn = fmaxf(m, tmax);
        const float alpha = __builtin_amdgcn_exp2f((m - mn) * sc);
        l *= alpha; m = mn;
#pragma unroll
        for (int c = 0; c < 4; ++c)
#pragma unroll
            for (int i = 0; i < 16; ++i) o[c][i] *= alpha;
    }
    const float mb = m * sc;
    float ls = 0.f;
#pragma unroll
    for (int b = 0; b < NBLK; ++b)
#pragma unroll
        for (int i = 0; i < 16; ++i) { float p = __builtin_amdgcn_exp2f(x[b][i] * sc - mb); if (SEL) { if (need_mask) p = (x[b][i] <= -1e29f) ? 0.f : p; } x[b][i] = p; ls += p; }
    l += ls;
}
DI void store_o(const f32x16 (&o)[4], float inv, unsigned char* orow, int hh) {
#pragma unroll
    for (int c = 0; c < 4; ++c)
#pragma unroll
        for (int g = 0; g < 4; ++g) {
            int w = 0; w = __builtin_amdgcn_cvt_pk_fp8_f32(o[c][4 * g + 0] * inv, o[c][4 * g + 1] * inv, w, false); w = __builtin_amdgcn_cvt_pk_fp8_f32(o[c][4 * g + 2] * inv, o[c][4 * g + 3] * inv, w, true);
            *(int*)(orow + 32 * c + 8 * g + 4 * hh) = w;
        }
}

DI void pswap(unsigned& d, unsigned& s_) { const auto r = __builtin_amdgcn_permlane32_swap(d, s_, false, false); const unsigned r0 = (unsigned)r[0], r1 = (unsigned)r[1]; d = r0; s_ = r1; }
DI void store_o_wide(const f32x16 (&o)[4], float inv, unsigned char* orow, int hh) {
#pragma unroll
    for (int c = 0; c < 4; ++c) {
        unsigned w[4];
#pragma unroll
        for (int g = 0; g < 4; ++g) {
            int t = 0; t = __builtin_amdgcn_cvt_pk_fp8_f32(o[c][4 * g + 0] * inv, o[c][4 * g + 1] * inv, t, false); t = __builtin_amdgcn_cvt_pk_fp8_f32(o[c][4 * g + 2] * inv, o[c][4 * g + 3] * inv, t, true);
            w[g] = (unsigned)t; }
        pswap(w[0], w[1]); pswap(w[2], w[3]);
        pswap(w[0], w[2]); pswap(w[1], w[3]);
        *(u32x4*)(orow + 32 * c + 16 * hh) = (u32x4){w[0], w[1], w[2], w[3]};
    }
}

struct CausalValid { int kbase, qpos, hh; DI bool operator()(int b, int i) const { return kbase + 32 * b + crow(i, hh) <= qpos; } };
DI void mla_unit(LAS unsigned char* lds, int b, int h, int qb, const bf16* __restrict__ QM, const bf16* __restrict__ KVM, const bf16* __restrict__ H, unsigned char* ATT) {
    constexpr int KP = 400;
    LAS unsigned char* kimg = lds; LAS unsigned char* vimg = lds + 64 * KP;
    int tid_ = threadIdx.x; asm volatile("" : "+v"(tid_));
    const int tid = tid_, lane = tid & 63, r = lane & 31, hh = lane >> 5; const int wid = __builtin_amdgcn_readfirstlane(tid >> 6);
    const size_t rowbase = (size_t)b * SEQ; const int q0 = qb * 256, qw = q0 + wid * 32;
    bf16x8 qf[12];
    { const bf16* qp = QM + (rowbase + qw + r) * 1536 + h * 192 + hh * 8;
#pragma unroll
      for (int s = 0; s < 12; ++s) qf[s] = *(const bf16x8*)(qp + 16 * s); }
    f32x16 o[4];
#pragma unroll
    for (int c = 0; c < 4; ++c)
#pragma unroll
        for (int i = 0; i < 16; ++i) o[c][i] = 0.f;
    float m = -1e30f, l = 0.f;
    const float sc = 0.07216878364870322f * LOG2E;
    const int NT = (q0 + 256) / 64, wlast = (qw + 31) / 64;
    u32x4 kreg[3], vreg[2];
#define MLA_LOAD(kt) do { \
        _Pragma("unroll") for (int i_ = 0; i_ < 3; ++i_) { const int n_ = tid + 512 * i_, row_ = n_ / 24, ch_ = n_ - row_ * 24; const size_t key_ = rowbase + (size_t)(kt) * 64 + row_; \
            const bf16* s_ = ch_ < 16 ? KVM + key_ * 2048 + h * 256 + ch_ * 8 : H + key_ * 4096 + 3840 + (ch_ - 16) * 8; kreg[i_] = *(const u32x4*)s_; } \
        _Pragma("unroll") for (int i_ = 0; i_ < 2; ++i_) { const int n_ = tid + 512 * i_, row_ = n_ >> 4, ch_ = n_ & 15; const size_t key_ = rowbase + (size_t)(kt) * 64 + row_; \
            vreg[i_] = *(const u32x4*)(KVM + key_ * 2048 + h * 256 + 128 + ch_ * 8); } } while (0)
#define MLA_STORE() do { \
        _Pragma("unroll") for (int i_ = 0; i_ < 3; ++i_) { const int n_ = tid + 512 * i_, row_ = n_ / 24, ch_ = n_ - row_ * 24; *(LAS u32x4*)(kimg + row_ * KP + ch_ * 16) = kreg[i_]; } \
        _Pragma("unroll") for (int i_ = 0; i_ < 2; ++i_) { const int n_ = tid + 512 * i_, row_ = n_ >> 4, ch_ = n_ & 15; *(LAS u32x4*)(vimg + off_b((unsigned)row_, (unsigned)ch_)) = vreg[i_]; } } while (0)
    MLA_LOAD(0);
    for (int kt = 0; kt < NT; ++kt) {
        __syncthreads();
        MLA_STORE();
        __syncthreads();
        if (kt + 1 < NT) MLA_LOAD(kt + 1);
        if (kt <= wlast) {
            f32x16 x[2];
            qk_tile<12, 2, KP, 4>(x, qf, kimg, r, hh);
            const bool need_mask = (kt * 64 + 63 > qw);
            const CausalValid cv{kt * 64, qw + r, hh};
            softmax_step<2, false>(x, o, m, l, sc, need_mask, cv);
            pv_tile<2>(o, x, vimg, lane);
        }
    }
#undef MLA_LOAD
#undef MLA_STORE
    const float lt = l + __shfl_xor(l, 32);
    store_o(o, 1.0f / lt, ATT + (rowbase + qw + r) * 2048 + 1024 + h * 128, hh);
}

struct BandValid { int kbase, mq, hh; DI bool operator()(int b, int i) const { const int k = kbase + 32 * b + crow(i, hh); return k <= mq && k >= mq - 128; } };
DI void dilated_block_unit(LAS unsigned char* lds, int b, int h, int r16b, int mb, const bf16* __restrict__ H, unsigned char* ATT) {
    int tid_ = threadIdx.x; asm volatile("" : "+v"(tid_));
    const int tid = tid_, lane = tid & 63; const int wid = __builtin_amdgcn_readfirstlane(tid >> 6); const int r16 = r16b + wid;
    LAS unsigned char* wlds = lds + wid * 16384;
    LAS unsigned char* kimg = wlds; LAS unsigned char* vimg = wlds + 8192;
    const int r = lane & 31, hh = lane >> 5;
    const size_t rowbase = (size_t)b * SEQ;
    const int tq = r16 + 16 * (32 * mb + r);
    bf16x8 qf[8];
    { const bf16* qp = H + (rowbase + tq) * EVEN_INP + h * 128 + hh * 8;
#pragma unroll
      for (int s = 0; s < 8; ++s) qf[s] = *(const bf16x8*)(qp + 16 * s); }
    f32x16 o[4];
#pragma unroll
    for (int c = 0; c < 4; ++c)
#pragma unroll
        for (int i = 0; i < 16; ++i) o[c][i] = 0.f;
    float m = -1e30f, l = 0.f;
    const float sc = 0.08838834764831845f * LOG2E;
    const bf16* Kb = H + 1024 + h * 128; const bf16* Vb = H + 2048 + h * 128;
    {
        LAS unsigned char* ks = lds; LAS unsigned char* vs = lds + 16384;
        const int pmin = 512 * mb + r16, pmax = pmin + 496;
        int t0 = 512 * mb + r16b - 128; if (t0 < 0) t0 = 0;
        int tl = 512 * mb + r16b + 7 + 496; if (tl > SEQ - 1) tl = SEQ - 1;
        u32x4 kr2[2], vr2[2];
#define DL_LOAD(t_) do { _Pragma("unroll") for (int i_ = 0; i_ < 2; ++i_) { const int n_ = tid + 512 * i_, row_ = n_ >> 4, ch_ = n_ & 15; int pos_ = (t_) + row_; if (pos_ > SEQ - 1) pos_ = SEQ - 1; \
            const size_t off_ = (rowbase + pos_) * EVEN_INP + ch_ * 8; kr2[i_] = *(const u32x4*)(Kb + off_); vr2[i_] = *(const u32x4*)(Vb + off_); } } while (0)
#define DL_STORE() do { _Pragma("unroll") for (int i_ = 0; i_ < 2; ++i_) { const int n_ = tid + 512 * i_, row_ = n_ >> 4, ch_ = n_ & 15; const unsigned ob_ = off_b((unsigned)row_, (unsigned)ch_); \
            *(LAS u32x4*)(ks + ob_) = kr2[i_]; *(LAS u32x4*)(vs + ob_) = vr2[i_]; } } while (0)
        DL_LOAD(t0);
        for (int t = t0; t <= tl; t += 64) {
            __syncthreads();
            DL_STORE();
            __syncthreads();
            if (t + 64 <= tl) DL_LOAD(t + 64);
            if (t <= pmax && t + 63 >= pmin - 128) {
                f32x16 x[2];
                qk_tile<8, 2, 0>(x, qf, ks, r, hh);
                const BandValid bv{t, tq, hh};
                softmax_step<2, true>(x, o, m, l, sc, true, bv);
                pv_tile<2>(o, x, vs, lane);
            }
        }
#undef DL_LOAD
#undef DL_STORE
        __syncthreads();
    }
    for (int pi = 1; pi < 3; ++pi) {
        const int dsh = 2 * pi, d = 1 << dsh, rd = r16 & (d - 1), c0 = (r16 - rd) >> dsh, st = 16 >> dsh;
        const int mq = c0 + st * (32 * mb + r), mq0 = c0 + st * (32 * mb), mq31 = mq0 + st * 31;
        int ms = mq0 - 128; if (ms < 0) ms = 0;
        for (int mt = ms; mt <= mq31; mt += 32) {
            u32x4 kr[8], vr[8];
#pragma unroll
            for (int i = 0; i < 8; ++i) { const int n = lane + 64 * i, row = n >> 4, ch = n & 15; int pos = rd + ((mt + row) << dsh); if (pos > SEQ - 1) pos = SEQ - 1;
                const size_t off = (rowbase + pos) * EVEN_INP + ch * 8; kr[i] = *(const u32x4*)(Kb + off); vr[i] = *(const u32x4*)(Vb + off); }
#pragma unroll
            for (int i = 0; i < 8; ++i) { const int n = lane + 64 * i, row = n >> 4, ch = n & 15; const unsigned ob = off_b((unsigned)row, (unsigned)ch);
                *(LAS u32x4*)(kimg + ob) = kr[i]; *(LAS u32x4*)(vimg + ob) = vr[i]; }
            LDS_WAIT();
            f32x16 x[1];
            qk_tile<8, 1, 0>(x, qf, kimg, r, hh);
            const bool need_mask = !(mt + 31 <= mq0 && mt >= mq31 - 128);
            const BandValid bv{mt, mq, hh};
            softmax_step<1, true>(x, o, m, l, sc, need_mask, bv);
            pv_tile<1>(o, x, vimg, lane);
            LDS_WAIT();
        }
    }
    const float lt = l + __shfl_xor(l, 32);
    store_o_wide(o, 1.0f / lt, ATT + (rowbase + tq) * 2048 + h * 128, hh);
}

constexpr float SB_CUT = 48.0f;
DI void stick_unit(LAS unsigned char* lds, int b, int h, int qb, const bf16* __restrict__ H, unsigned char* ATT, bool early_exit) {
    constexpr int KP = 272;
    LAS unsigned char* kimg = lds; LAS unsigned char* vimg = lds + 64 * KP; LAS unsigned* flags = (LAS unsigned*)(lds + 64 * KP + 16384);
    int tid_ = threadIdx.x; asm volatile("" : "+v"(tid_));
    const int tid = tid_, lane = tid & 63, r = lane & 31, hh = lane >> 5; const int wid = __builtin_amdgcn_readfirstlane(tid >> 6);
    const size_t rowbase = (size_t)b * SEQ; const int q0 = qb * 256, qw = q0 + wid * 32;
    bf16x8 qf[8];
    { const bf16* qp = H + (rowbase + qw + r) * ODD_IN + h * 128 + hh * 8;
#pragma unroll
      for (int s = 0; s < 8; ++s) { const u32x4 qv = *(const u32x4*)(qp + 16 * s); u32x4 qs;
#pragma unroll
          for (int e = 0; e < 4; ++e) qs[e] = cvtpk(bflo(qv[e]) * (0.08838834764831845f * LOG2E), bfhi(qv[e]) * (0.08838834764831845f * LOG2E));
          qf[s] = __builtin_bit_cast(bf16x8, qs); } }
    f32x16 o[4];
#pragma unroll
    for (int c = 0; c < 4; ++c)
#pragma unroll
        for (int i = 0; i < 16; ++i) o[c][i] = 0.f;
    float R = 0.f;
    const int NT = (q0 + 256) / 64, wlast = (qw + 31) / 64;
    const bf16* Kb = H + 2048 + h * 128; const bf16* Vb = H + 4096 + h * 128;
    u32x4 kreg[2], vreg[2];
#define SB_LOAD(kt) do { _Pragma("unroll") for (int i_ = 0; i_ < 2; ++i_) { const int n_ = tid + 512 * i_, row_ = n_ >> 4, ch_ = n_ & 15; const size_t off_ = (rowbase + (size_t)(kt) * 64 + row_) * ODD_IN + ch_ * 8; \
            kreg[i_] = *(const u32x4*)(Kb + off_); vreg[i_] = *(const u32x4*)(Vb + off_); } } while (0)
#define SB_STORE() do { _Pragma("unroll") for (int i_ = 0; i_ < 2; ++i_) { const int n_ = tid + 512 * i_, row_ = n_ >> 4, ch_ = n_ & 15; \
            *(LAS u32x4*)(kimg + row_ * KP + ch_ * 16) = kreg[i_]; *(LAS u32x4*)(vimg + off_b((unsigned)row_, (unsigned)ch_)) = vreg[i_]; } } while (0)
    if (tid < 8) flags[tid] = 0u;
    bool wdone = false;
    SB_LOAD(NT - 1);
    for (int kt = NT - 1; kt >= 0; --kt) {
        __syncthreads();
        if (early_exit) { unsigned alld = 1u;
#pragma unroll
            for (int w = 0; w < 8; ++w) alld &= flags[w];
            if (alld) break; }
        SB_STORE();
        __syncthreads();
        if (kt > 0) SB_LOAD(kt - 1);
        if (kt <= wlast && !wdone) {
            f32x16 x[2];
            qk_tile<8, 2, KP>(x, qf, kimg, r, hh);
            const bool need_mask = (kt * 64 + 63 >= qw);
            const int qpos = qw + r, kbase = kt * 64;
            f32x16 y[2];
#pragma unroll
            for (int bb = 0; bb < 2; ++bb)
#pragma unroll
                for (int i = 0; i < 16; ++i) {
                    const float z = x[bb][i];
                    const float a = __builtin_amdgcn_logf(1.0f + __builtin_amdgcn_exp2f(-fabsf(z)));
                    float lb = -(fmaxf(-z, 0.f) + a), lr = -(fmaxf(z, 0.f) + a);
                    if (need_mask) { const bool ok = kbase + 32 * bb + crow(i, hh) < qpos; lb = ok ? lb : -1e30f; lr = ok ? lr : 0.f; }
                    x[bb][i] = lb; y[bb][i] = lr;
                }
            float G[8], Go[8], Ta[8];
#pragma unroll
            for (int gi = 0; gi < 8; ++gi) { const int bb = gi >> 2, i0 = 4 * (gi & 3); const float g_ = (y[bb][i0] + y[bb][i0 + 1]) + (y[bb][i0 + 2] + y[bb][i0 + 3]); float gl_, gh_; xhalf(g_, gl_, gh_); G[gi] = gl_ + gh_; Go[gi] = gh_; }
            float accs = 0.f;
#pragma unroll
            for (int gi = 7; gi >= 0; --gi) { Ta[gi] = accs + (hh == 0 ? Go[gi] : 0.f); accs += G[gi]; }
#pragma unroll
            for (int gi = 0; gi < 8; ++gi) { const int bb = gi >> 2, i0 = 4 * (gi & 3);
                const float base = R + Ta[gi];
                const float e3 = base, e2 = e3 + y[bb][i0 + 3], e1 = e2 + y[bb][i0 + 2], e0 = e1 + y[bb][i0 + 1];
                x[bb][i0 + 0] = __builtin_amdgcn_exp2f(x[bb][i0 + 0] + e0);
                x[bb][i0 + 1] = __builtin_amdgcn_exp2f(x[bb][i0 + 1] + e1);
                x[bb][i0 + 2] = __builtin_amdgcn_exp2f(x[bb][i0 + 2] + e2);
                x[bb][i0 + 3] = __builtin_amdgcn_exp2f(x[bb][i0 + 3] + e3); }
            R += accs;
            pv_tile<2>(o, x, vimg, lane);
        }
        if (early_exit) { const bool done = (kt <= wlast) ? (R < -SB_CUT * LOG2E) : false; const bool wd = __all(done) || kt == 0; wdone = wd; if (lane == 0) flags[wid] = wd ? 1u : 0u; }
    }
#undef SB_LOAD
#undef SB_STORE
    store_o_wide(o, 1.0f, ATT + (rowbase + qw + r) * 2048 + h * 128, hh);
    __syncthreads();
}
}


DI void ln_rows(const float* __restrict__ Y, const float* __restrict__ gain, const float* __restrict__ bias, float* XO, bf16* XOB, int gw, int NGW, int lane_in) {
    int lane = lane_in; asm volatile("" : "+v"(lane));
    for (int row = gw; row < MTOK; row += NGW) {
        const f32x4* yr = (const f32x4*)(Y + (size_t)row * DM) + lane;
        f32x4 v[8]; float s = 0.f;
#pragma unroll
        for (int j = 0; j < 8; ++j) { v[j] = yr[64 * j]; s += (v[j][0] + v[j][1]) + (v[j][2] + v[j][3]); }
        const float mean = wave_sum(s) * (1.0f / DM); float s2 = 0.f;
#pragma unroll
        for (int j = 0; j < 8; ++j) { v[j] = v[j] - mean; s2 += (v[j][0] * v[j][0] + v[j][1] * v[j][1]) + (v[j][2] * v[j][2] + v[j][3] * v[j][3]); }
        const float rstd = 1.0f / sqrtf(wave_sum(s2) * (1.0f / DM) + LN_EPS);
        f32x4* xo = (f32x4*)(XO + (size_t)row * DM) + lane; u32x2* xb = (u32x2*)(XOB + (size_t)row * DM) + lane;
#pragma unroll
        for (int j = 0; j < 8; ++j) { const f32x4 g = ((const f32x4*)gain)[lane + 64 * j], bb = ((const f32x4*)bias)[lane + 64 * j];
            const f32x4 y = v[j] * rstd * g + bb; if (XO) xo[64 * j] = y; u32x2 w; w.x = pk2(y[0], y[1]); w.y = pk2(y[2], y[3]); xb[64 * j] = w; }
    }
}

DI void ln_rows_b(const bf16* __restrict__ Y, const float* __restrict__ gain, const float* __restrict__ bias, bf16* XOB, int gw, int NGW, int lane_in) {
    int lane = lane_in; asm volatile("" : "+v"(lane));
    for (int row = gw; row < MTOK; row += NGW) {
        float v[4][8]; float s = 0.f;
#pragma unroll
        for (int j = 0; j < 4; ++j) { const u32x4 w = *(const u32x4*)(Y + (size_t)row * DM + 8 * (lane + 64 * j));
            v[j][0] = bflo(w[0]); v[j][1] = bfhi(w[0]); v[j][2] = bflo(w[1]); v[j][3] = bfhi(w[1]); v[j][4] = bflo(w[2]); v[j][5] = bfhi(w[2]); v[j][6] = bflo(w[3]); v[j][7] = bfhi(w[3]);
#pragma unroll
            for (int k = 0; k < 8; ++k) s += v[j][k]; }
        const float mean = wave_sum(s) * (1.0f / DM); float s2 = 0.f;
#pragma unroll
        for (int j = 0; j < 4; ++j)
#pragma unroll
            for (int k = 0; k < 8; ++k) { v[j][k] -= mean; s2 += v[j][k] * v[j][k]; }
        const float rstd = 1.0f / sqrtf(wave_sum(s2) * (1.0f / DM) + LN_EPS);
#pragma unroll
        for (int j = 0; j < 4; ++j) { const int col = 8 * (lane + 64 * j);
            const f32x4 g0 = *(const f32x4*)(gain + col), g1 = *(const f32x4*)(gain + col + 4), b0 = *(const f32x4*)(bias + col), b1 = *(const f32x4*)(bias + col + 4);
            u32x4 w; w.x = pk2(v[j][0] * rstd * g0[0] + b0[0], v[j][1] * rstd * g0[1] + b0[1]); w.y = pk2(v[j][2] * rstd * g0[2] + b0[2], v[j][3] * rstd * g0[3] + b0[3]);
            w.z = pk2(v[j][4] * rstd * g1[0] + b1[0], v[j][5] * rstd * g1[1] + b1[1]); w.w = pk2(v[j][6] * rstd * g1[2] + b1[2], v[j][7] * rstd * g1[3] + b1[3]);
            *(u32x4*)(XOB + (size_t)row * DM + col) = w; }
    }
}

DI unsigned fkey(float v) { const unsigned u = __builtin_bit_cast(unsigned, v); return (u & 0x80000000u) ? ~u : (u | 0x80000000u); }
DI float unkey(unsigned k) { const unsigned u = (k & 0x80000000u) ? (k ^ 0x80000000u) : ~k; return __builtin_bit_cast(float, u); }
DI unsigned umin2(unsigned a, unsigned b) { return a < b ? a : b; }
DI void sort16_desc(unsigned (&v)[16]) {
#pragma unroll
    for (int k = 2; k <= 16; k <<= 1)
#pragma unroll
        for (int j = k >> 1; j > 0; j >>= 1)
#pragma unroll
            for (int i = 0; i < 16; ++i) { const int l = i ^ j; if (l > i) { const unsigned a = v[i], b = v[l], hi = umax2(a, b), lo = umin2(a, b); if ((i & k) == 0) { v[i] = hi; v[l] = lo; } else { v[i] = lo; v[l] = hi; } } }
}
DI void merge16_desc(unsigned (&top)[16], const unsigned (&bt)[16]) {
#pragma unroll
    for (int i = 0; i < 16; ++i) top[i] = umax2(top[i], bt[15 - i]);
#pragma unroll
    for (int j = 8; j > 0; j >>= 1)
#pragma unroll
        for (int i = 0; i < 16; ++i) { const int l = i ^ j; if (l > i) { const unsigned a = top[i], b = top[l]; top[i] = umax2(a, b); top[l] = umin2(a, b); } }
}
DI void top16_row(const bf16* __restrict__ s, unsigned (&top)[16]) {
#pragma unroll
    for (int i = 0; i < 16; ++i) top[i] = 0u;
    for (int b = 0; b < 8; ++b) {
        unsigned bt[16];
#pragma unroll
        for (int q = 0; q < 2; ++q) { const u32x4 v = *(const u32x4*)(s + 16 * b + 8 * q);
#pragma unroll
            for (int e = 0; e < 4; ++e) { bt[8 * q + 2 * e] = (fkey(bflo(v[e])) & ~127u) | (unsigned)(16 * b + 8 * q + 2 * e); bt[8 * q + 2 * e + 1] = (fkey(bfhi(v[e])) & ~127u) | (unsigned)(16 * b + 8 * q + 2 * e + 1); } }
        sort16_desc(bt);
        merge16_desc(top, bt);
    }
}
DI unsigned cand_key(unsigned k1, unsigned k2) { const float s = unkey(k1 & ~127u) + unkey(k2 & ~127u); return (fkey(s) & ~0x3FFFu) | ((k1 & 127u) << 7) | (k2 & 127u); }
DI void peer_topk(const bf16* __restrict__ SC, int* IDX, float* G, int gw, int NGW, int lane_in) {
    int lane = lane_in; asm volatile("" : "+v"(lane));
    for (int wt = gw; wt < MTOK * 8 / 64; wt += NGW) {
        const int tk_ = lane >> 3, task_ = wt + (tk_ >> 2) * (MTOK / 8), item = (4 * task_ + (tk_ & 3)) * 8 + (lane & 7);
        const bf16* s = SC + (size_t)item * 256;
        unsigned k1[16], k2[16];
        top16_row(s, k1);
        top16_row(s + 128, k2);
        unsigned top[16], bt[16];
#pragma unroll
        for (int b = 0; b < 16; ++b) top[b] = cand_key(k1[0], k2[b]);
#pragma unroll
        for (int a = 1; a < 16; ++a) bt[a - 1] = cand_key(k1[a], k2[0]);
        bt[15] = 0u;
        merge16_desc(top, bt);
        bt[0] = cand_key(k1[1], k2[1]); bt[1] = cand_key(k1[1], k2[2]); bt[2] = cand_key(k1[1], k2[3]); bt[3] = cand_key(k1[1], k2[4]); bt[4] = cand_key(k1[1], k2[5]); bt[5] = cand_key(k1[1], k2[6]); bt[6] = cand_key(k1[1], k2[7]);
        bt[7] = cand_key(k1[2], k2[1]); bt[8] = cand_key(k1[2], k2[2]); bt[9] = cand_key(k1[2], k2[3]); bt[10] = cand_key(k1[2], k2[4]);
        bt[11] = cand_key(k1[3], k2[1]); bt[12] = cand_key(k1[3], k2[2]); bt[13] = cand_key(k1[3], k2[3]);
        bt[14] = cand_key(k1[4], k2[1]); bt[15] = cand_key(k1[4], k2[2]);
        sort16_desc(bt); merge16_desc(top, bt);
        bt[0] = cand_key(k1[5], k2[1]); bt[1] = cand_key(k1[6], k2[1]); bt[2] = cand_key(k1[7], k2[1]);
#pragma unroll
        for (int i = 3; i < 16; ++i) bt[i] = 0u;
        merge16_desc(top, bt);
        float ev[16]; float sum = 0.f; const float mx = unkey(top[0] & ~0x3FFFu);
#pragma unroll
        for (int i = 0; i < 16; ++i) { ev[i] = __expf(unkey(top[i] & ~0x3FFFu) - mx); sum += ev[i]; }
        const float rs = 1.0f / sum;
#pragma unroll
        for (int q = 0; q < 4; ++q) {
            *(u32x4*)(IDX + (size_t)item * 16 + 4 * q) = (u32x4){top[4 * q] & 0x3FFFu, top[4 * q + 1] & 0x3FFFu, top[4 * q + 2] & 0x3FFFu, top[4 * q + 3] & 0x3FFFu};
            *(f32x4*)(G + (size_t)item * 16 + 4 * q) = (f32x4){ev[4 * q] * rs, ev[4 * q + 1] * rs, ev[4 * q + 2] * rs, ev[4 * q + 3] * rs}; }
    }
}

typedef int i32x8 __attribute__((ext_vector_type(8)));
constexpr int UD_TOK = 4, UD_TS = 2064, UD_XS = UD_TOK * UD_TS, UD_LIST = 256, UD_SA = 272, UD_SB = 144, UD_STG = 16 * UD_SA + 16 * UD_SB, UD_DOT = UD_TOK * 128 * 4, UD_WAVE_LDS = UD_XS + UD_LIST * 4 + UD_STG + UD_DOT;
constexpr int UD_RSH = 12, UD_NR = 16384 >> UD_RSH, VS_RSH = 14, VS_NR = 16384 >> VS_RSH;
constexpr int UD_NBSP = 3;
DI void udots_groups(const unsigned char* __restrict__ UQ, LAS float* dl, const i32x8 (&Bf)[4 * UD_NBSP], LAS const unsigned char* xs, LAS unsigned* list, LAS unsigned char* stg, int n, int lane) {
    const int r = lane & 15, kg = lane >> 4;
    const int ngr = (n + 15) >> 4;
    if (ngr == 0) return;
    const unsigned long long uqa_ = (unsigned long long)UQ;
    const unsigned char* UQs = (const unsigned char*)(((unsigned long long)(unsigned)__builtin_amdgcn_readfirstlane((int)(uqa_ >> 32)) << 32) | (unsigned long long)(unsigned)__builtin_amdgcn_readfirstlane((int)uqa_));
    LAS unsigned char* stgA = stg; LAS unsigned char* stgB = stg + 16 * UD_SA;
    unsigned la[4], lb[2], na[4], nb[2];
    u32x4 Ra[6], Rb[6];
#if U_FP4
#define UD_ROWS(o4, o2, g_) do { const int gg_ = (g_) < ngr ? (g_) : ngr - 1; \
        _Pragma("unroll") for (int j_ = 0; j_ < 4; ++j_) (o4)[j_] = (list[16 * gg_ + 4 * j_ + (lane >> 4)] & 0x3FFFu) * 1024u + 16u * (lane & 15); } while (0)
#define UD_LOAD(R, o4, o2, sp_) do { \
        _Pragma("unroll") for (int j_ = 0; j_ < 4; ++j_) (R)[j_] = *(const u32x4*)(UQs + (o4)[j_] + 256 * (sp_)); } while (0)
#define UD_STEP(R, sp_, NEXTLOAD) do { \
        _Pragma("unroll") for (int j_ = 0; j_ < 4; ++j_) *(LAS u32x4*)(stgA + (4 * j_ + (lane >> 4)) * UD_SA + 16 * (lane & 15)) = (R)[j_]; \
        __builtin_amdgcn_sched_barrier(0); NEXTLOAD; __builtin_amdgcn_sched_barrier(0); \
        LDS_WAIT(); \
        _Pragma("unroll") for (int k4_ = 0; k4_ < 4; ++k4_) { \
            const u32x4 a4_ = *(const LAS u32x4*)(stgA + r * UD_SA + 16 * (4 * k4_ + kg)); \
            const i32x8 A_ = {(int)a4_[0], (int)a4_[1], (int)a4_[2], (int)a4_[3], 0, 0, 0, 0}; \
            i32x8 B_; if ((sp_) < UD_NBSP) B_ = Bf[((sp_) < UD_NBSP ? 4 * (sp_) + k4_ : 0)]; else { LAS const unsigned char* xb_ = xs + (r & 3) * UD_TS; const int ks_ = 4 * (sp_) + k4_; \
                const u32x4 b0_ = *(const LAS u32x4*)(xb_ + 32 * (4 * ks_ + (kg >> 1)) + 16 * (kg & 1)), b1_ = *(const LAS u32x4*)(xb_ + 32 * (4 * ks_ + 2 + (kg >> 1)) + 16 * (kg & 1)); \
                B_ = (i32x8){(int)b0_[0], (int)b0_[1], (int)b0_[2], (int)b0_[3], (int)b1_[0], (int)b1_[1], (int)b1_[2], (int)b1_[3]}; } \
            acc = __builtin_amdgcn_mfma_scale_f32_16x16x128_f8f6f4(A_, B_, acc, 4  , 0  , 0, 127, 0, 127); } \
        LDS_WAIT(); } while (0)
#else
#define UD_ROWS(o4, o2, g_) do { const int gg_ = (g_) < ngr ? (g_) : ngr - 1; \
        _Pragma("unroll") for (int j_ = 0; j_ < 4; ++j_) (o4)[j_] = (list[16 * gg_ + 4 * j_ + (lane >> 4)] & 0x3FFFu) * 1536u + 16u * (lane & 15); \
        _Pragma("unroll") for (int j_ = 0; j_ < 2; ++j_) (o2)[j_] = (list[16 * gg_ + 8 * j_ + (lane >> 3)] & 0x3FFFu) * 1536u + 1024u + 16u * (lane & 7); } while (0)
#define UD_LOAD(R, o4, o2, sp_) do { \
        _Pragma("unroll") for (int j_ = 0; j_ < 4; ++j_) (R)[j_] = *(const u32x4*)(UQs + (o4)[j_] + 256 * (sp_)); \
        _Pragma("unroll") for (int j_ = 0; j_ < 2; ++j_) (R)[4 + j_] = *(const u32x4*)(UQs + (o2)[j_] + 128 * (sp_)); } while (0)
#define UD_STEP(R, sp_, NEXTLOAD) do { \
        _Pragma("unroll") for (int j_ = 0; j_ < 4; ++j_) *(LAS u32x4*)(stgA + (4 * j_ + (lane >> 4)) * UD_SA + 16 * (lane & 15)) = (R)[j_]; \
        _Pragma("unroll") for (int j_ = 0; j_ < 2; ++j_) *(LAS u32x4*)(stgB + (8 * j_ + (lane >> 3)) * UD_SB + 16 * (lane & 7)) = (R)[4 + j_]; \
        __builtin_amdgcn_sched_barrier(0); NEXTLOAD; __builtin_amdgcn_sched_barrier(0);     \
        LDS_WAIT(); \
        _Pragma("unroll") for (int k4_ = 0; k4_ < 4; ++k4_) { \
            const u32x4 a4_ = *(const LAS u32x4*)(stgA + r * UD_SA + 16 * (4 * k4_ + kg)); const u32x2 a2_ = *(const LAS u32x2*)(stgB + r * UD_SB + 8 * (4 * k4_ + kg)); \
            const i32x8 A_ = {(int)a4_[0], (int)a4_[1], (int)a4_[2], (int)a4_[3], (int)a2_[0], (int)a2_[1], 0, 0}; \
            i32x8 B_; if ((sp_) < UD_NBSP) B_ = Bf[((sp_) < UD_NBSP ? 4 * (sp_) + k4_ : 0)]; else { LAS const unsigned char* xb_ = xs + (r & 3) * UD_TS; const int ks_ = 4 * (sp_) + k4_; \
                const u32x4 b0_ = *(const LAS u32x4*)(xb_ + 32 * (4 * ks_ + (kg >> 1)) + 16 * (kg & 1)), b1_ = *(const LAS u32x4*)(xb_ + 32 * (4 * ks_ + 2 + (kg >> 1)) + 16 * (kg & 1)); \
                B_ = (i32x8){(int)b0_[0], (int)b0_[1], (int)b0_[2], (int)b0_[3], (int)b1_[0], (int)b1_[1], (int)b1_[2], (int)b1_[3]}; } \
            acc = __builtin_amdgcn_mfma_scale_f32_16x16x128_f8f6f4(A_, B_, acc, 2  , 0  , 0, 127, 0, 127); } \
        LDS_WAIT(); } while (0)
#endif
    UD_ROWS(la, lb, 0); UD_LOAD(Ra, la, lb, 0); UD_LOAD(Rb, la, lb, 1);
#pragma unroll 1
    for (int g = 0; g < ngr; ++g) {
        f32x4 acc = (f32x4){0.f, 0.f, 0.f, 0.f};
        UD_ROWS(na, nb, g + 1);
        UD_STEP(Ra, 0, UD_LOAD(Ra, la, lb, 2));
        UD_STEP(Rb, 1, UD_LOAD(Rb, la, lb, 3));
        UD_STEP(Ra, 2, UD_LOAD(Ra, na, nb, 0));
        UD_STEP(Rb, 3, UD_LOAD(Rb, na, nb, 1));
        const u32x4 en = *(const LAS u32x4*)(list + 16 * g + 4 * kg);
#pragma unroll
        for (int j = 0; j < 4; ++j) { const unsigned e4 = en[j]; if (!(e4 >> 31) && (int)((e4 >> 21) & 7u) == r) dl[r * 128 + ((e4 >> 14) & 127u)] = acc[j]; }
#pragma unroll
        for (int j = 0; j < 4; ++j) la[j] = na[j];
        lb[0] = nb[0]; lb[1] = nb[1];
    }
#undef UD_ROWS
#undef UD_LOAD
#undef UD_STEP
}
DI void peer_udots_mfma(const bf16* __restrict__ X1, const int* __restrict__ IDX, const unsigned char* __restrict__ UQ, float* __restrict__ DOT, LAS unsigned char* wlds, int gw, int NGW, int lane_in) {
    int lane = lane_in; asm volatile("" : "+v"(lane));
    LAS unsigned char* xs = wlds; LAS unsigned* list = (LAS unsigned*)(wlds + UD_XS);
    LAS unsigned char* stg = wlds + UD_XS + UD_LIST * 4; LAS float* dl = (LAS float*)(wlds + UD_XS + UD_LIST * 4 + UD_STG);
    const int r = lane & 15, kg = lane >> 4;
    for (int task = gw; task < MTOK / UD_TOK; task += NGW) {
        const int t0 = task * UD_TOK;
#pragma unroll
        for (int tok = 0; tok < UD_TOK; ++tok) { unsigned pw[8];
#pragma unroll
            for (int q = 0; q < 8; ++q) { const u32x2 v = *(const u32x2*)(X1 + (size_t)(t0 + tok) * DM + 4 * (lane + 64 * q));
                int w = 0; w = __builtin_amdgcn_cvt_pk_fp8_f32(bflo(v[0]), bfhi(v[0]), w, false); w = __builtin_amdgcn_cvt_pk_fp8_f32(bflo(v[1]), bfhi(v[1]), w, true); pw[q] = (unsigned)w; }
            *(LAS u32x4*)(xs + tok * UD_TS + 32 * lane) = (u32x4){pw[0], pw[1], pw[2], pw[3]}; *(LAS u32x4*)(xs + tok * UD_TS + 32 * lane + 16) = (u32x4){pw[4], pw[5], pw[6], pw[7]};
        }
        LDS_WAIT();
        i32x8 Bf[4 * UD_NBSP];
#pragma unroll
        for (int ks = 0; ks < 4 * UD_NBSP; ++ks) { LAS const unsigned char* xb = xs + (r & 3) * UD_TS;
            const u32x4 b0 = *(const LAS u32x4*)(xb + 32 * (4 * ks + (kg >> 1)) + 16 * (kg & 1)), b1 = *(const LAS u32x4*)(xb + 32 * (4 * ks + 2 + (kg >> 1)) + 16 * (kg & 1));
            Bf[ks] = (i32x8){(int)b0[0], (int)b0[1], (int)b0[2], (int)b0[3], (int)b1[0], (int)b1[1], (int)b1[2], (int)b1[3]}; }
        LDS_WAIT();
#pragma unroll
        for (int tok = 0; tok < UD_TOK; ++tok) { LAS int* idl = (LAS int*)(xs + tok * UD_TS); idl[lane] = IDX[(size_t)(t0 + tok) * 128 + lane]; idl[64 + lane] = IDX[(size_t)(t0 + tok) * 128 + 64 + lane]; }
        LDS_WAIT();
#pragma unroll 1
        for (int s = 0; s < UD_NR; ++s) {
            int n = 0;
#pragma unroll
            for (int tok = 0; tok < UD_TOK; ++tok) {
                const LAS int* idl = (const LAS int*)(xs + tok * UD_TS); const int id0 = idl[lane], id1 = idl[64 + lane];
                const bool m0 = (id0 >> UD_RSH) == s, m1 = (id1 >> UD_RSH) == s;
                const unsigned long long b0 = __ballot(m0), b1 = __ballot(m1);
                const unsigned long long lt = (1ull << lane) - 1ull;
                const int c0 = __popcll(b0), c1 = __popcll(b1);
                if (n + c0 + c1 > UD_LIST - 16) {
                    for (int i = n + lane; i < ((n + 15) & ~15); i += 64) list[i] = 0x80000000u;
                    LDS_WAIT(); udots_groups(UQ, dl, Bf, xs, list, stg, n, lane); LDS_WAIT(); n = 0; }
                if (m0) list[n + __popcll(b0 & lt)] = (unsigned)id0 | ((unsigned)lane << 14) | ((unsigned)tok << 21);
                if (m1) list[n + c0 + __popcll(b1 & lt)] = (unsigned)id1 | ((unsigned)(lane + 64) << 14) | ((unsigned)tok << 21);
                n += c0 + c1;
            }
            for (int i = n + lane; i < ((n + 15) & ~15); i += 64) list[i] = 0x80000000u;
            LDS_WAIT();
            udots_groups(UQ, dl, Bf, xs, list, stg, n, lane);
            LDS_WAIT();
        }
#pragma unroll
        for (int j = 0; j < 8; ++j) DOT[(size_t)t0 * 128 + lane + 64 * j] = dl[lane + 64 * j];
        LDS_WAIT();
    }
}

DI float gelu_exact(float x) { return 0.5f * x * (1.0f + erff(x * 0.7071067811865476f)); }
constexpr int VS_TOK = 2, VS_CAP = 320;
template <bool LAST> DI void peer_vsweep_ln(const bf16* __restrict__ X1, const int* __restrict__ IDX, const float* __restrict__ G, const float* __restrict__ DOT, const unsigned char* __restrict__ VQ,
                       const float* __restrict__ SU, const float* __restrict__ SV, const float* __restrict__ gain, const float* __restrict__ bias, float* XO, bf16* XOB, unsigned char* X8O, LAS unsigned char* wlds, int gw, int NGW, int task_end, int lane_in) {
    int lane = lane_in; asm volatile("" : "+v"(lane));
    LAS unsigned* list = (LAS unsigned*)wlds; LAS unsigned* wl = (LAS unsigned*)(wlds + VS_CAP * 4); LAS unsigned* segc = (LAS unsigned*)(wlds + VS_CAP * 8);
    typedef _Float16 h2 __attribute__((ext_vector_type(2)));
    for (int task = gw; task < task_end; task += NGW) {
        const int t0 = task * VS_TOK;
        int ids[VS_TOK][2]; float wts[VS_TOK][2];
#pragma unroll
        for (int tok = 0; tok < VS_TOK; ++tok) { const size_t b = (size_t)(t0 + tok) * 128;
            ids[tok][0] = IDX[b + lane]; ids[tok][1] = IDX[b + 64 + lane];
            wts[tok][0] = G[b + lane] * SV[ids[tok][0]] * gelu_exact(DOT[b + lane] * SU[ids[tok][0]]);
            wts[tok][1] = G[b + 64 + lane] * SV[ids[tok][1]] * gelu_exact(DOT[b + 64 + lane] * SU[ids[tok][1]]); }
        h2 acc[VS_TOK][16];
#pragma unroll
        for (int tok = 0; tok < VS_TOK; ++tok)
#pragma unroll
            for (int k = 0; k < 16; ++k) acc[tok][k] = (h2){(_Float16)0.f, (_Float16)0.f};
        int n = 0;
#pragma unroll 1
        for (int s = 0; s < VS_NR; ++s) {
#pragma unroll
            for (int tok = 0; tok < VS_TOK; ++tok) {
                const bool m0 = (ids[tok][0] >> VS_RSH) == s, m1 = (ids[tok][1] >> VS_RSH) == s;
                const unsigned long long b0 = __ballot(m0), b1 = __ballot(m1); const unsigned long long lt = (1ull << lane) - 1ull;
                const int c0 = __popcll(b0), c1 = __popcll(b1), c = c0 + c1, cp = (c + 3) & ~3;
                if (m0) { const int p = n + __popcll(b0 & lt); list[p] = (unsigned)ids[tok][0]; const h2 t = {(_Float16)wts[tok][0], (_Float16)wts[tok][0]}; wl[p] = __builtin_bit_cast(unsigned, t); }
                if (m1) { const int p = n + c0 + __popcll(b1 & lt); list[p] = (unsigned)ids[tok][1]; const h2 t = {(_Float16)wts[tok][1], (_Float16)wts[tok][1]}; wl[p] = __builtin_bit_cast(unsigned, t); }
                if (lane < cp - c) { list[n + c + lane] = 0u; wl[n + c + lane] = 0u; }
                if (lane == 0) segc[s * VS_TOK + tok] = (unsigned)(cp >> 2);
                n += cp;
            }
        }
        LDS_WAIT();
        {
            const int ngp = n >> 2;
            u32x4 A4[4], B4[4], C4[4];
#define VS_LOAD(b4, g_) do { const int gg_ = (g_) < ngp ? (g_) : (ngp > 0 ? ngp - 1 : 0); const u32x4 i4_ = *(const LAS u32x4*)(list + 4 * gg_); _Pragma("unroll") for (int j_ = 0; j_ < 4; ++j_) { \
            const unsigned idx_ = (unsigned)__builtin_amdgcn_readfirstlane((int)i4_[j_]); (b4)[j_] = *(const u32x4*)(VQ + (size_t)idx_ * 1024 + 16 * lane); } } while (0)
#define VS_PROC(b4, g_) do { const u32x4 w4_ = *(const LAS u32x4*)(wl + 4 * (g_)); _Pragma("unroll") for (int j = 0; j < 4; ++j) { const h2 wh = __builtin_bit_cast(h2, (unsigned)__builtin_amdgcn_readfirstlane((int)w4_[j])); \
            _Pragma("unroll") for (int w = 0; w < 4; ++w) { \
                acc[tok][4 * w] += wh * __builtin_amdgcn_cvt_scalef32_pk_f16_fp4((b4)[j][w], 1.0f, 0); acc[tok][4 * w + 1] += wh * __builtin_amdgcn_cvt_scalef32_pk_f16_fp4((b4)[j][w], 1.0f, 1); \
                acc[tok][4 * w + 2] += wh * __builtin_amdgcn_cvt_scalef32_pk_f16_fp4((b4)[j][w], 1.0f, 2); acc[tok][4 * w + 3] += wh * __builtin_amdgcn_cvt_scalef32_pk_f16_fp4((b4)[j][w], 1.0f, 3); } } } while (0)
            if (ngp == 0 && lane < 4) list[lane] = 0u;
            VS_LOAD(A4, 0);
            int gs = 0;
#pragma unroll 1
            for (int s = 0; s < VS_NR; ++s) {
#pragma unroll
                for (int tok = 0; tok < VS_TOK; ++tok) {
                    const int ge = gs + __builtin_amdgcn_readfirstlane((int)segc[s * VS_TOK + tok]);
#pragma unroll 1
                    for (int g = gs; g < ge; ++g) {
                        VS_LOAD(B4, g + 1); VS_PROC(A4, g);
#pragma unroll
                        for (int j = 0; j < 4; ++j) { A4[j] = B4[j]; }
                    }
                    gs = ge;
                }
            }
#undef VS_PROC
#undef VS_LOAD
        }
        LDS_WAIT();
#pragma unroll
        for (int tok = 0; tok < VS_TOK; ++tok) { const int t = t0 + tok;
            float sm = 0.f; float y32[32];
#pragma unroll
            for (int k = 0; k < 16; ++k) { y32[2 * k] = (float)acc[tok][k][0]; y32[2 * k + 1] = (float)acc[tok][k][1]; }
#pragma unroll
            for (int q = 0; q < 8; ++q) { const u32x2 v = *(const u32x2*)(X1 + (size_t)t * DM + 4 * (lane + 64 * q));
                y32[4 * q] += DN_ALPHA * bflo(v[0]); y32[4 * q + 1] += DN_ALPHA * bfhi(v[0]); y32[4 * q + 2] += DN_ALPHA * bflo(v[1]); y32[4 * q + 3] += DN_ALPHA * bfhi(v[1]); }
#pragma unroll
            for (int k = 0; k < 32; ++k) sm += y32[k];
            const float mean = wave_sum(sm) * (1.0f / DM); float s2 = 0.f;
#pragma unroll
            for (int k = 0; k < 32; ++k) { y32[k] -= mean; s2 += y32[k] * y32[k]; }
            const float rstd = 1.0f / sqrtf(wave_sum(s2) * (1.0f / DM) + LN_EPS);
#pragma unroll
            for (int q = 0; q < 8; ++q) { const int col = 4 * (lane + 64 * q); const f32x4 ga = *(const f32x4*)(gain + col), ba = *(const f32x4*)(bias + col); f32x4 y;
                y[0] = y32[4 * q] * rstd * ga[0] + ba[0]; y[1] = y32[4 * q + 1] * rstd * ga[1] + ba[1]; y[2] = y32[4 * q + 2] * rstd * ga[2] + ba[2]; y[3] = y32[4 * q + 3] * rstd * ga[3] + ba[3];
                if constexpr (LAST) *(f32x4*)(XO + (size_t)t * DM + col) = y; else { *(u32x2*)(XOB + (size_t)t * DM + col) = (u32x2){pk2(y[0], y[1]), pk2(y[2], y[3])};
                    int w8 = 0; w8 = __builtin_amdgcn_cvt_pk_fp8_f32(y[0], y[1], w8, false); w8 = __builtin_amdgcn_cvt_pk_fp8_f32(y[2], y[3], w8, true); *(int*)(X8O + (size_t)t * DM + col) = w8; } } }
    }
}

#ifndef MK_ONE_LAUNCH
#define MK_ONE_LAUNCH 1
#endif
constexpr int N_PHASES = 19;
struct Args { const float* in[15]; float* out; unsigned char* ws; int ph_lo, ph_hi; };
__global__ void __launch_bounds__(NTHREADS, 2) fwd_kernel(Args args) {
    extern __shared__ __attribute__((aligned(16))) unsigned char lds_raw[];
    LAS unsigned char* lds = (LAS unsigned char*)lds_raw;
    volatile LAS unsigned* MISC = (volatile LAS unsigned*)(lds + MISC_OFF);
    const int tid = threadIdx.x, lane = tid & 63; const int wave = __builtin_amdgcn_readfirstlane(tid >> 6);
    const int G = gridDim.x; const int bx = blockIdx.x; const int vcu = (G % 8 == 0) ? (bx % 8) * (G / 8) + bx / 8 : bx;
    const int gw = vcu * NWAVES + wave, NGW = G * NWAVES;
    unsigned char* ws = args.ws;
    if (tid < 32) MISC[tid] = 0u;
    __syncthreads();
    const int lo = args.ph_lo, hi = args.ph_hi;
    XcdBarrier bar; bar.bar = (unsigned*)(ws + WS_CTL) + CW_BAR; bar.x = 0; bar.st = nullptr;
    if (hi - lo > 1) bar = xcd_barrier_post((unsigned*)(ws + WS_CTL) + CW_BAR, MISC + 8);
#define IN(k) (lo <= (k) && (k) < hi)
#define SEAM(k) do { if ((k) > lo) xcd_barrier(bar); } while (0)

    const float* x_in = args.in[0];
    bf16* XB = (bf16*)(ws + WS_XB); float* XF = (float*)(ws + WS_XF);
    bf16* Hb = (bf16*)(ws + WS_A); float* Yf = (float*)(ws + WS_A); bf16* QP = (bf16*)(ws + WS_A + 128 * MiB); float* SC = (float*)(ws + WS_A);
    bf16* QM = (bf16*)(ws + WS_B); bf16* KVM = (bf16*)(ws + WS_B + 48 * MiB); float* X1 = (float*)(ws + WS_B);
    unsigned char* ATT = ws + WS_C; bf16* X1B = (bf16*)(ws + WS_C);
    float* SSQ = (float*)(ws + WS_SSQ); int* IDX = (int*)(ws + WS_IDX); float* GT = (float*)(ws + WS_G);
    const float* T128 = (const float*)(ws + WS_T128); const float* T64 = (const float*)(ws + WS_T64);

    if (IN(0)) {
        ProArgs pa; pa.x = args.in[0]; pa.a_w_in = args.in[1]; pa.b_q_norm = args.in[2]; pa.b_w_q_b = args.in[3]; pa.b_kv_norm = args.in[4]; pa.b_w_kv_b = args.in[5]; pa.ab_w_out = args.in[6];
        pa.c_w_in = args.in[7]; pa.c_w_out = args.in[8]; pa.peer_w_query = args.in[9]; pa.peer_sub_keys = args.in[10]; pa.peer_u = args.in[11]; pa.peer_v = args.in[12]; pa.ws = ws;
        prologue(pa, lds, gw, NGW, wave, lane);
    }
#pragma unroll
    for (int layer = 0; layer < 2; ++layer) {
        const int pb = 1 + 9 * layer;
        float* xout = layer == 0 ? nullptr : args.out;
        bf16* xoutb = layer == 0 ? XB : nullptr;
        const float* ln_g = args.in[13] + (size_t)layer * 2 * DM; const float* ln_b = args.in[14] + (size_t)layer * 2 * DM;
        if (layer == 0) {
            if (IN(pb + 0)) { SEAM(pb + 0);
                pg8::Gemm g{(const bf16*)(ws + WS_X8), (const bf16*)(ws + WS_WIN0), MTOK, EVEN_INP, DM / 2, DM / 2, DM / 2, 0, 0}; pg8::StaticOrder S; S.init(MTOK, EVEN_INP, G, bx);
                pg8::EpiIn0 E{Hb, EVEN_INP, T128, T64, SSQ, SEQ};
                pg8::gemm_phase<pg8::EpiIn0, pg8::StaticOrder, true, false, true>(lds, g, S, E); }
            if (IN(pb + 1)) { SEAM(pb + 1);
#pragma unroll 1
                for (int l2 = 0; l2 < 2; ++l2) {
                    pg8::Gemm g{(const bf16*)(ws + WS_KB + (size_t)l2 * MiB), (const bf16*)(ws + WS_WPQ + (size_t)l2 * 8 * MiB), DM, DM, 256, 256, DM, 0, 256}; pg8::StaticOrder S; S.init(DM, DM, G, (bx + G - 128 - 64 * l2) % G);
                    pg8::EpiPlain E{(bf16*)(ws + WS_WS + (size_t)l2 * 8 * MiB), DM, 1.0f};
                    pg8::gemm_phase<pg8::EpiPlain, pg8::StaticOrder, true, true>(lds, g, S, E); __syncthreads(); }
                { pg8::Gemm g{Hb + 3072, (const bf16*)(ws + WS_WQB), MTOK, 1536, 512, EVEN_INP, 512, 0, 0}; pg8::StaticOrder S; S.init(MTOK, 1536, G, bx);
                  pg8::EpiMlaQ E{QM, 1536, T64, SSQ, SEQ};
                  pg8::gemm_phase<pg8::EpiMlaQ, pg8::StaticOrder, true, true>(lds, g, S, E); }
                __syncthreads();
                { pg8::Gemm g{Hb + 3584, (const bf16*)(ws + WS_WKVB), MTOK, 2048, 256, EVEN_INP, 256, 0, 0}; pg8::StaticOrder S; S.init(MTOK, 2048, G, bx);
                  pg8::EpiMlaKV E{KVM, 2048, SSQ};
                  pg8::gemm_phase<pg8::EpiMlaKV, pg8::StaticOrder, true, true>(lds, g, S, E); } }
            if (IN(pb + 2)) { SEAM(pb + 2);
                for (int ub = vcu; ub < 512; ub += G) { const int r16b = (ub & 1) * 8, mbk = (ub >> 1) & 15, hq = (ub >> 5) & 7, bq = ub >> 8;
                    att::dilated_block_unit(lds, bq, hq, r16b, mbk, Hb, ATT); }
                __syncthreads();
                for (int up = vcu; up < 256; up += G) { const int bh = up >> 4, s = up & 15;
                    att::mla_unit(lds, bh >> 3, bh & 7, s, QM, KVM, Hb, ATT); __syncthreads();
                    att::mla_unit(lds, bh >> 3, bh & 7, 31 - s, QM, KVM, Hb, ATT); __syncthreads(); } }
        } else {
            if (IN(pb + 0)) { SEAM(pb + 0);
                pg8::Gemm g{(const bf16*)(ws + WS_X8), (const bf16*)(ws + WS_W8IN1), MTOK, ODD_IN, DM / 2, DM / 2, DM / 2, 0, 0}; pg8::StaticOrder S; S.init(MTOK, ODD_IN, G, bx);
                pg8::EpiPlain E{Hb, ODD_IN, 1.0f};
                pg8::gemm_phase<pg8::EpiPlain, pg8::StaticOrder, true, false, true>(lds, g, S, E); }
            if (IN(pb + 2)) { SEAM(pb + 2);
                for (int u = vcu; u < 1024; u += G) { const int bh = u >> 5, qb = u & 31;
                    att::stick_unit(lds, bh >> 4, bh & 15, qb, Hb, ATT, true); } }
        }
        if (IN(pb + 3)) { SEAM(pb + 3);
            pg8::Gemm g{(const bf16*)ATT, (const bf16*)(ws + (layer == 0 ? WS_WOUT0 : WS_WOUT1)), MTOK, DM, DM / 2, DM / 2, DM / 2, 0, 0}; pg8::StaticOrder S; S.init(MTOK, DM, G, bx);
            pg8::EpiResB E{XB, (bf16*)Yf, DM, DN_ALPHA};
            pg8::gemm_phase<pg8::EpiResB, pg8::StaticOrder, true, false, true>(lds, g, S, E); }
        if (IN(pb + 4)) { SEAM(pb + 4); ln_rows_b((const bf16*)Yf, ln_g, ln_b, X1B, gw, NGW, lane); }
        if (IN(pb + 5)) { SEAM(pb + 5);
            pg8::Gemm g{X1B, (const bf16*)(ws + WS_WS + (size_t)layer * 8 * MiB), MTOK, DM, DM, DM, DM, 0, 0}; pg8::StaticOrder S; S.init(MTOK, DM, G, bx);
            pg8::EpiPlain E{(bf16*)SC, DM, 1.0f};
            pg8::gemm_phase<pg8::EpiPlain, pg8::StaticOrder, true, true>(lds, g, S, E); }
        float* DOT = (float*)(ws + WS_A + 128 * MiB);
        if (IN(pb + 6)) { SEAM(pb + 6);
#pragma unroll 1
            for (int st = gw; st < MTOK / 8; st += NGW) {
                peer_topk((const bf16*)SC, IDX, GT, st, MTOK / 8, lane);
                asm volatile("s_waitcnt vmcnt(0)" ::: "memory");
                peer_udots_mfma(X1B, IDX, ws + WS_UV + (size_t)layer * 48 * MiB, DOT, lds + wave * UD_WAVE_LDS, st, MTOK / 8, lane);
                asm volatile("s_waitcnt vmcnt(0)" ::: "memory");
#pragma unroll 1
                for (int hf = 0; hf < 2; ++hf) { const int tk0 = (4 / VS_TOK) * (st + hf * (MTOK / 8));
                    if (layer == 0) peer_vsweep_ln<false>(X1B, IDX, GT, DOT, ws + WS_UV + (size_t)layer * 48 * MiB + 24 * MiB, (const float*)(ws + WS_QS) + (size_t)layer * 2 * NEXP, (const float*)(ws + WS_QS) + (size_t)layer * 2 * NEXP + NEXP,
                                   ln_g + DM, ln_b + DM, xout, xoutb, ws + WS_X8, lds + wave * UD_WAVE_LDS, tk0, 1, tk0 + 4 / VS_TOK, lane);
                    else peer_vsweep_ln<true>(X1B, IDX, GT, DOT, ws + WS_UV + (size_t)layer * 48 * MiB + 24 * MiB, (const float*)(ws + WS_QS) + (size_t)layer * 2 * NEXP, (const float*)(ws + WS_QS) + (size_t)layer * 2 * NEXP + NEXP,
                                   ln_g + DM, ln_b + DM, xout, xoutb, ws + WS_X8, lds + wave * UD_WAVE_LDS, tk0, 1, tk0 + 4 / VS_TOK, lane); } } }
    }
#undef IN
#undef SEAM
}

extern "C" void kernel_launch(void* const* d_in, const int* in_sizes, int n_in, void* d_out, int out_size, void* d_ws, size_t ws_size, hipStream_t stream) {
    static int grid = 0;
    if (grid == 0) {
        if (n_in != 15 || in_sizes[0] != MTOK * DM || out_size != MTOK * DM || ws_size < WS_END) {
            fprintf(stderr, "kernel_launch: unexpected shapes: n_in %d in0 %d out %d ws %zu (need %zu); nothing launched\n", n_in, n_in > 0 ? in_sizes[0] : -1, out_size, ws_size, (size_t)WS_END); grid = -1; return; }
        int dev = 0, cus = 0, per_cu = 0;
        if (hipGetDevice(&dev) != hipSuccess || hipDeviceGetAttribute(&cus, hipDeviceAttributeMultiprocessorCount, dev) != hipSuccess) { fprintf(stderr, "kernel_launch: device query failed\n"); grid = -1; return; }
        if (hipFuncSetAttribute((const void*)fwd_kernel, hipFuncAttributeMaxDynamicSharedMemorySize, LDS_BYTES) != hipSuccess) { fprintf(stderr, "kernel_launch: hipFuncSetAttribute failed\n"); grid = -1; return; }
        if (hipOccupancyMaxActiveBlocksPerMultiprocessor(&per_cu, (const void*)fwd_kernel, NTHREADS, LDS_BYTES) != hipSuccess || per_cu < 1)
            fprintf(stderr, "kernel_launch: note: occupancy query reports %d workgroups per CU\n", per_cu);
        (void)hipGetLastError();
        grid = cus;
    }
    if (grid < 0) return;
    if (hipMemsetAsync((char*)d_ws + WS_CTL, 0, CTL_ZERO_BYTES, stream) != hipSuccess) { fprintf(stderr, "kernel_launch: memset failed\n"); return; }
    Args a{};
    for (int i = 0; i < 15; ++i) a.in[i] = (const float*)d_in[i];
    a.out = (float*)d_out; a.ws = (unsigned char*)d_ws;
#if MK_ONE_LAUNCH
    a.ph_lo = 0; a.ph_hi = N_PHASES;
    hipLaunchKernelGGL(fwd_kernel, dim3(grid), dim3(NTHREADS), LDS_BYTES, stream, a);
#endif
    const hipError_t le = hipPeekAtLastError();
    if (le != hipSuccess) fprintf(stderr, "kernel_launch: launch failed: %s\n", hipGetErrorName(le));
}
```

```cpp
#include <hip/hip_runtime.h>
#include <cstdio>
#include <cstdint>

namespace pg8 {
#define PG8_LAS __attribute__((address_space(3)))
typedef unsigned short bf16_t;
typedef short bf16x8 __attribute__((ext_vector_type(8)));
typedef float f32x4 __attribute__((ext_vector_type(4)));
typedef unsigned u32x4 __attribute__((ext_vector_type(4)));
typedef int pg8_i32x4 __attribute__((ext_vector_type(4)));
typedef int pg8_i32x8 __attribute__((ext_vector_type(8)));
constexpr int BM = 256, BK = 64, HALF = 128, HTB = HALF * BK * 2  , STAGE_BYTES = 8 * HTB, NXCD = 8, WGM = 4;

__host__ __device__ __forceinline__ int lds_byte(int r, int c) { const int st = (r >> 4) * 2 + (c >> 5), rr = r & 15, cc = c & 31, ob = rr * 64 + cc * 2; return st * 1024 + (ob ^ (((ob >> 9) & 1) << 5)); }
__host__ __device__ __forceinline__ void stage_rc(int b, int& R, int& C) { const int st = b / 1024, sb = b % 1024, swz = sb ^ (((sb >> 9) & 1) << 5); R = (st >> 1) * 16 + swz / 64; C = (st & 1) * 32 + (swz % 64) / 2; }
__host__ __device__ __forceinline__ int perm32(int rho) { const int n = rho >> 4, i = rho & 15; return 8 * (i >> 2) + 4 * n + (i & 3); }

struct Unit { int pm, pn; };
struct Gemm { const bf16_t* A; const bf16_t* Bt; int M, N, K, lda, ldb, apn, bpm; };

struct StaticOrder {
    int nM, nN, nwg, G, c;
    __host__ __device__ void init(int M, int N, int G_, int c_) { nM = M / BM; nN = N / BM; nwg = nM * nN; G = G_; c = c_; }
    __host__ __device__ bool next(int i, Unit& u) const {
        const long L = (long)i * G + c; if (L >= nwg) return false;
        int wgid = (int)L; { const int q = nwg / NXCD, r = nwg % NXCD, xcd = wgid % NXCD, off = wgid / NXCD; wgid = (xcd < r ? xcd * (q + 1) : r * (q + 1) + (xcd - r) * q) + off; }
        const int nig = WGM * nN, gid = wgid / nig, fm = gid * WGM, gsz = (nM - fm) < WGM ? (nM - fm) : WGM;
        u.pm = fm + ((wgid % nig) % gsz); u.pn = (wgid % nig) / gsz; return true;
    }
    __device__ __forceinline__ void a_ready(const Unit&) const {}
    __device__ __forceinline__ void done(const Unit&) const {}
};

__device__ __forceinline__ unsigned cvt_pk_bf16(float lo, float hi) { unsigned r; asm volatile("v_cvt_pk_bf16_f32 %0, %1, %2" : "=v"(r) : "v"(lo), "v"(hi)); return r; }
typedef float f32x2 __attribute__((ext_vector_type(2)));


struct EpiPlain {
    static constexpr bool PERM = true, AFTER_DRAIN = false;
    bf16_t* O; int ldc; float oscale;
    __device__ __forceinline__ void operator()(const f32x4 (&acc)[2][2][4][2], const Unit& u, int wr, int wc, int fr, int fq) const {
        int row0 = u.pm * BM + wr * 64 + fr, col0 = u.pn * BM + wc * 32 + 8 * fq; asm volatile("" : "+v"(row0), "+v"(col0));
#pragma unroll
        for (int ai = 0; ai < 2; ++ai)
#pragma unroll
            for (int m = 0; m < 4; ++m) { bf16_t* rowp = O + (size_t)(row0 + ai * HALF + m * 16) * ldc + col0;
#pragma unroll
                for (int bj = 0; bj < 2; ++bj) { const f32x4 v0 = acc[ai][bj][m][0] * oscale, v1 = acc[ai][bj][m][1] * oscale;
                    u32x4 w; w.x = cvt_pk_bf16(v0[0], v0[1]); w.y = cvt_pk_bf16(v0[2], v0[3]); w.z = cvt_pk_bf16(v1[0], v1[1]); w.w = cvt_pk_bf16(v1[2], v1[3]);
                    *(u32x4*)(rowp + bj * HALF) = w; } }
    }
};
struct EpiF32 {
    static constexpr bool PERM = false, AFTER_DRAIN = false;
    float* O; int ldc;
    __device__ __forceinline__ void operator()(const f32x4 (&acc)[2][2][4][2], const Unit& u, int wr, int wc, int fr, int fq) const {
        int row0 = u.pm * BM + wr * 64 + fr, col0 = u.pn * BM + wc * 32 + 4 * fq; asm volatile("" : "+v"(row0), "+v"(col0));
#pragma unroll
        for (int ai = 0; ai < 2; ++ai)
#pragma unroll
            for (int m = 0; m < 4; ++m) { float* rowp = O + (size_t)(row0 + ai * HALF + m * 16) * ldc + col0;
#pragma unroll
                for (int bj = 0; bj < 2; ++bj)
#pragma unroll
                    for (int n = 0; n < 2; ++n) *(f32x4*)(rowp + bj * HALF + n * 16) = acc[ai][bj][m][n]; }
    }
};
struct EpiRes {
    static constexpr bool PERM = false, AFTER_DRAIN = false;
    const float* R; float* O; int ldc; float alpha;
    __device__ __forceinline__ void operator()(const f32x4 (&acc)[2][2][4][2], const Unit& u, int wr, int wc, int fr, int fq) const {
        int row0 = u.pm * BM + wr * 64 + fr, col0 = u.pn * BM + wc * 32 + 4 * fq; asm volatile("" : "+v"(row0), "+v"(col0));
#pragma unroll
        for (int ai = 0; ai < 2; ++ai)
#pragma unroll
            for (int m = 0; m < 4; ++m) { const size_t off = (size_t)(row0 + ai * HALF + m * 16) * ldc + col0;
#pragma unroll
                for (int bj = 0; bj < 2; ++bj)
#pragma unroll
                    for (int n = 0; n < 2; ++n) { const f32x4 r = *(const f32x4*)(R + off + bj * HALF + n * 16); *(f32x4*)(O + off + bj * HALF + n * 16) = r * alpha + acc[ai][bj][m][n]; }
                asm volatile("" ::: "memory"); }
    }
};
struct EpiResB {
    static constexpr bool PERM = true, AFTER_DRAIN = false;
    const bf16_t* R; bf16_t* O; int ldc; float alpha;
    __device__ __forceinline__ void operator()(const f32x4 (&acc)[2][2][4][2], const Unit& u, int wr, int wc, int fr, int fq) const {
        int row0 = u.pm * BM + wr * 64 + fr, col0 = u.pn * BM + wc * 32 + 8 * fq; asm volatile("" : "+v"(row0), "+v"(col0));
#pragma unroll
        for (int ai = 0; ai < 2; ++ai)
#pragma unroll
            for (int m = 0; m < 4; ++m) { const size_t off = (size_t)(row0 + ai * HALF + m * 16) * ldc + col0;
#pragma unroll
                for (int bj = 0; bj < 2; ++bj) { const u32x4 rw = *(const u32x4*)(R + off + bj * HALF);
                    const f32x4 r0 = {__builtin_bit_cast(float, rw.x << 16), __builtin_bit_cast(float, rw.x & 0xffff0000u), __builtin_bit_cast(float, rw.y << 16), __builtin_bit_cast(float, rw.y & 0xffff0000u)};
                    const f32x4 r1 = {__builtin_bit_cast(float, rw.z << 16), __builtin_bit_cast(float, rw.z & 0xffff0000u), __builtin_bit_cast(float, rw.w << 16), __builtin_bit_cast(float, rw.w & 0xffff0000u)};
                    const f32x4 v0 = r0 * alpha + acc[ai][bj][m][0], v1 = r1 * alpha + acc[ai][bj][m][1];
                    u32x4 w; w.x = cvt_pk_bf16(v0[0], v0[1]); w.y = cvt_pk_bf16(v0[2], v0[3]); w.z = cvt_pk_bf16(v1[0], v1[1]); w.w = cvt_pk_bf16(v1[2], v1[3]);
                    *(u32x4*)(O + off + bj * HALF) = w; }
                asm volatile("" ::: "memory"); }
    }
};
__device__ __forceinline__ void rope8(f32x4& v0, f32x4& v1, const f32x4 c0, const f32x4 c1) {
    const f32x4 a = v0, b = v1;
    v0[0] = a[0] * c0[0] - a[1] * c0[1]; v0[1] = a[0] * c0[1] + a[1] * c0[0];
    v0[2] = a[2] * c0[2] - a[3] * c0[3]; v0[3] = a[2] * c0[3] + a[3] * c0[2];
    v1[0] = b[0] * c1[0] - b[1] * c1[1]; v1[1] = b[0] * c1[1] + b[1] * c1[0];
    v1[2] = b[2] * c1[2] - b[3] * c1[3]; v1[3] = b[2] * c1[3] + b[3] * c1[2];
}
struct EpiIn0 {
    static constexpr bool PERM = true, AFTER_DRAIN = false;
    bf16_t* O; int ldc; const float* T128; const float* T64; float* ssq; int seq;
    __device__ __forceinline__ void operator()(const f32x4 (&acc)[2][2][4][2], const Unit& u, int wr, int wc, int fr, int fq) const {
        int row0 = u.pm * BM + wr * 64 + fr, col0 = u.pn * BM + wc * 32 + 8 * fq; asm volatile("" : "+v"(row0), "+v"(col0));     const int pn = u.pn;
        const int pi0 = 16 * wc + 4 * fq;
#pragma unroll
        for (int ai = 0; ai < 2; ++ai)
#pragma unroll
            for (int m = 0; m < 4; ++m) { const int row = row0 + ai * HALF + m * 16; bf16_t* rowp = O + (size_t)row * ldc + col0; const int pos = row & (seq - 1);
                float sq = 0.f;
#pragma unroll
                for (int bj = 0; bj < 2; ++bj) { f32x4 v0 = acc[ai][bj][m][0], v1 = acc[ai][bj][m][1];
                    if (pn < 8) { const float* t = T128 + ((size_t)pos * 64 + pi0) * 2; rope8(v0, v1, *(const f32x4*)t, *(const f32x4*)(t + 4)); }
                    else if (pn == 15) { if (bj == 0 && wc < 2) { const float* t = T64 + ((size_t)pos * 32 + pi0) * 2; rope8(v0, v1, *(const f32x4*)t, *(const f32x4*)(t + 4)); } }
                    else if (pn >= 12) { sq += (v0[0] * v0[0] + v0[1] * v0[1]) + (v0[2] * v0[2] + v0[3] * v0[3]) + (v1[0] * v1[0] + v1[1] * v1[1]) + (v1[2] * v1[2] + v1[3] * v1[3]); }
                    if (pn != 15 || (bj == 0 && wc < 2)) {
                        u32x4 w; w.x = cvt_pk_bf16(v0[0], v0[1]); w.y = cvt_pk_bf16(v0[2], v0[3]); w.z = cvt_pk_bf16(v1[0], v1[1]); w.w = cvt_pk_bf16(v1[2], v1[3]);
                        *(u32x4*)(rowp + bj * HALF) = w; } }
                if (pn >= 12 && pn < 15) { sq += __shfl_xor(sq, 16); sq += __shfl_xor(sq, 32); if (fq == 0) ssq[(size_t)row * 12 + (pn - 12) * 4 + wc] = sq; }
                asm volatile("" ::: "memory"); }
    }
};
struct EpiMlaQ {
    static constexpr bool PERM = true, AFTER_DRAIN = false;
    bf16_t* O; int ldc; const float* T64; const float* ssq; int seq;
    __device__ __forceinline__ void operator()(const f32x4 (&acc)[2][2][4][2], const Unit& u, int wr, int wc, int fr, int fq) const {
        int row0 = u.pm * BM + wr * 64 + fr, col0 = u.pn * BM + wc * 32 + 8 * fq; asm volatile("" : "+v"(row0), "+v"(col0));
#pragma unroll
        for (int ai = 0; ai < 2; ++ai)
#pragma unroll
            for (int m = 0; m < 4; ++m) { const int row = row0 + ai * HALF + m * 16; bf16_t* rowp = O + (size_t)row * ldc + col0; const int pos = row & (seq - 1);
                const f32x4 s0 = *(const f32x4*)(ssq + (size_t)row * 12), s1 = *(const f32x4*)(ssq + (size_t)row * 12 + 4);
                const float rstd = 1.0f / sqrtf(((s0[0] + s0[1]) + (s0[2] + s0[3]) + (s1[0] + s1[1]) + (s1[2] + s1[3])) * (1.0f / 512.0f) + 1e-6f);
#pragma unroll
                for (int bj = 0; bj < 2; ++bj) { f32x4 v0 = acc[ai][bj][m][0] * rstd, v1 = acc[ai][bj][m][1] * rstd;
                    const int w0 = (col0 + bj * HALF) % 192;
                    if (w0 >= 128) { const float* t = T64 + ((size_t)pos * 32 + ((w0 - 128) >> 1)) * 2; rope8(v0, v1, *(const f32x4*)t, *(const f32x4*)(t + 4)); }
                    u32x4 w; w.x = cvt_pk_bf16(v0[0], v0[1]); w.y = cvt_pk_bf16(v0[2], v0[3]); w.z = cvt_pk_bf16(v1[0], v1[1]); w.w = cvt_pk_bf16(v1[2], v1[3]);
                    *(u32x4*)(rowp + bj * HALF) = w; }
                asm volatile("" ::: "memory"); }
    }
};
struct EpiMlaKV {
    static constexpr bool PERM = true, AFTER_DRAIN = false;
    bf16_t* O; int ldc; const float* ssq;
    __device__ __forceinline__ void operator()(const f32x4 (&acc)[2][2][4][2], const Unit& u, int wr, int wc, int fr, int fq) const {
        int row0 = u.pm * BM + wr * 64 + fr, col0 = u.pn * BM + wc * 32 + 8 * fq; asm volatile("" : "+v"(row0), "+v"(col0));
#pragma unroll
        for (int ai = 0; ai < 2; ++ai)
#pragma unroll
            for (int m = 0; m < 4; ++m) { const int row = row0 + ai * HALF + m * 16; bf16_t* rowp = O + (size_t)row * ldc + col0;
                const f32x4 s0 = *(const f32x4*)(ssq + (size_t)row * 12 + 8);
                const float rstd = 1.0f / sqrtf(((s0[0] + s0[1]) + (s0[2] + s0[3])) * (1.0f / 256.0f) + 1e-6f);
#pragma unroll
                for (int bj = 0; bj < 2; ++bj) { const f32x4 v0 = acc[ai][bj][m][0] * rstd, v1 = acc[ai][bj][m][1] * rstd;
                    u32x4 w; w.x = cvt_pk_bf16(v0[0], v0[1]); w.y = cvt_pk_bf16(v0[2], v0[3]); w.z = cvt_pk_bf16(v1[0], v1[1]); w.w = cvt_pk_bf16(v1[2], v1[3]);
                    *(u32x4*)(rowp + bj * HALF) = w; }
                asm volatile("" ::: "memory"); }
    }
};

template <class Epi, class Sched, bool ALIGN_EPI = false, bool SP2 = false, bool FP8 = false>
__device__ __forceinline__ void gemm_phase(PG8_LAS unsigned char* lds, const Gemm g, const Sched& S, const Epi& E) {
    int tid_ = threadIdx.x; asm volatile("" : "+v"(tid_));
    const int tid = tid_, wid = __builtin_amdgcn_readfirstlane(tid >> 6), lane = tid & 63, wr = wid >> 2, wc = wid & 3, fr = lane & 15, fq = lane >> 4;
    int K = g.K; asm volatile("" : "+s"(K)); const int nt = K / BK;
    unsigned voffA[2], voffB[2];
#pragma unroll
    for (int i = 0; i < 2; ++i) { int R, C; stage_rc(tid * 16 + i * 8192, R, C); const int Rb = Epi::PERM ? ((R & ~31) + perm32(R & 31)) : R;
        voffA[i] = (unsigned)(R * g.lda + C) * 2u; voffB[i] = (unsigned)(Rb * g.ldb + C) * 2u; }
    const size_t kstep = (size_t)(BK * 2);
    const size_t hstepA = (size_t)HALF * g.lda * 2, hstepB = (size_t)HALF * g.ldb * 2;
    const size_t tstepA = 2 * hstepA, tstepB = 2 * hstepB; const size_t apnb = (size_t)g.apn * 2, bpmb = (size_t)g.bpm * 2;
    const unsigned ldsw = (unsigned)wid * 1024u;
    const int aoff = lds_byte(wr * 64 + fr, fq * 8), boff = lds_byte(wc * 32 + fr, fq * 8);
#define PG8_SA(b, h) (((b) * 2 + (h)) * HTB)
#define PG8_SB(b, h) ((4 + (b) * 2 + (h)) * HTB)
#define PG8_STAGE(bufoff, gbase, voff) do { _Pragma("unroll") for (int _i = 0; _i < 2; ++_i) { unsigned vo_ = (voff)[_i]; asm volatile("" : "+v"(vo_));     \
        __builtin_amdgcn_global_load_lds((const unsigned*)((const char*)(gbase) + vo_), (PG8_LAS unsigned*)(lds + (bufoff) + ldsw + _i * 8192), 16, 0, 0); } } while (0)
#define PG8_LDA(dst, b, h) do { _Pragma("unroll") for (int m = 0; m < 4; ++m) { const pg8_i32x4 lo_ = *(const PG8_LAS pg8_i32x4*)(lds + PG8_SA(b, h) + aoff + m * 2048), hi_ = *(const PG8_LAS pg8_i32x4*)(lds + PG8_SA(b, h) + aoff + m * 2048 + 1024); dst[m] = __builtin_shufflevector(lo_, hi_, 0, 1, 2, 3, 4, 5, 6, 7); } } while (0)
#define PG8_LDB(dst, b, h) do { _Pragma("unroll") for (int n = 0; n < 2; ++n) { const pg8_i32x4 lo_ = *(const PG8_LAS pg8_i32x4*)(lds + PG8_SB(b, h) + boff + n * 2048), hi_ = *(const PG8_LAS pg8_i32x4*)(lds + PG8_SB(b, h) + boff + n * 2048 + 1024); dst[n] = __builtin_shufflevector(lo_, hi_, 0, 1, 2, 3, 4, 5, 6, 7); } } while (0)
#define PG8_MMA(ai, bj, At, Bt) do { __builtin_amdgcn_s_setprio(1); _Pragma("unroll") for (int m = 0; m < 4; ++m) _Pragma("unroll") for (int n = 0; n < 2; ++n) { \
        if constexpr (FP8) acc[ai][bj][m][n] = __builtin_amdgcn_mfma_scale_f32_16x16x128_f8f6f4(Bt[n], At[m], acc[ai][bj][m][n], 1, 0, 0, 0, 0, 0);     \
        else { const pg8_i32x8 bv_ = Bt[n], av_ = At[m];     \
               acc[ai][bj][m][n] = __builtin_amdgcn_mfma_f32_16x16x32_bf16(__builtin_bit_cast(bf16x8, __builtin_shufflevector(bv_, bv_, 0, 1, 2, 3)), __builtin_bit_cast(bf16x8, __builtin_shufflevector(av_, av_, 0, 1, 2, 3)), acc[ai][bj][m][n], 0, 0, 0); \
               acc[ai][bj][m][n] = __builtin_amdgcn_mfma_f32_16x16x32_bf16(__builtin_bit_cast(bf16x8, __builtin_shufflevector(bv_, bv_, 4, 5, 6, 7)), __builtin_bit_cast(bf16x8, __builtin_shufflevector(av_, av_, 4, 5, 6, 7)), acc[ai][bj][m][n], 0, 0, 0); } } \
        __builtin_amdgcn_s_setprio(0); } while (0)
#define PG8_WAIT_V(n) asm volatile("s_waitcnt vmcnt(" #n ")" ::: "memory")
#define PG8_WAIT_L(n) asm volatile("s_waitcnt lgkmcnt(" #n ")" ::: "memory")
#define PG8_BAR __builtin_amdgcn_s_barrier()
#define PG8_SCHED __builtin_amdgcn_sched_barrier(0)
    Unit cur, nxt; int ui = 0;
    if (!S.next(0, cur)) return;
    f32x4 acc[2][2][4][2];
    pg8_i32x8 At[4], B0[2], B1[2];
    const char* cA = (const char*)g.A + (size_t)cur.pm * tstepA + (size_t)cur.pn * apnb; const char* cB = (const char*)g.Bt + (size_t)cur.pn * tstepB + (size_t)cur.pm * bpmb;
    S.a_ready(cur);
    if constexpr (SP2) {
        PG8_STAGE(PG8_SB(0, 0), cB, voffB); PG8_STAGE(PG8_SB(0, 1), cB + hstepB, voffB); PG8_STAGE(PG8_SA(0, 0), cA, voffA); PG8_STAGE(PG8_SA(0, 1), cA + hstepA, voffA);
        if (wr == 1) PG8_BAR;
        PG8_WAIT_V(2); PG8_BAR;
        PG8_STAGE(PG8_SB(1, 0), cB + kstep, voffB); PG8_STAGE(PG8_SA(1, 0), cA + kstep, voffA); PG8_STAGE(PG8_SB(1, 1), cB + hstepB + kstep, voffB);
        PG8_WAIT_V(6); PG8_BAR;
    } else {
        PG8_STAGE(PG8_SB(0, 0), cB, voffB); PG8_STAGE(PG8_SA(0, 0), cA, voffA); PG8_STAGE(PG8_SB(0, 1), cB + hstepB, voffB); PG8_STAGE(PG8_SA(0, 1), cA + hstepA, voffA);
        if (wr == 1) PG8_BAR;
        PG8_WAIT_V(4); PG8_BAR;
        PG8_STAGE(PG8_SB(1, 0), cB + kstep, voffB); PG8_STAGE(PG8_SA(1, 0), cA + kstep, voffA); PG8_STAGE(PG8_SB(1, 1), cB + hstepB + kstep, voffB);
        PG8_WAIT_V(6); PG8_BAR;
    }
    __builtin_amdgcn_sched_barrier(0);
#pragma unroll
    for (int a = 0; a < 2; ++a)
#pragma unroll
        for (int b = 0; b < 2; ++b)
#pragma unroll
            for (int m = 0; m < 4; ++m)
#pragma unroll
                for (int n = 0; n < 2; ++n) acc[a][b][m][n] = (f32x4){0.f, 0.f, 0.f, 0.f};
    __builtin_amdgcn_sched_barrier(0);
    for (;;) {
        const bool has_next = S.next(ui + 1, nxt);
        const char* nA = has_next ? (const char*)g.A + (size_t)nxt.pm * tstepA + (size_t)nxt.pn * apnb : cA; const char* nB = has_next ? (const char*)g.Bt + (size_t)nxt.pn * tstepB + (size_t)nxt.pm * bpmb : cB;
        for (int t = 0; t < nt; t += 2) {
            const bool last = (t == nt - 2);
            const char* a1 = cA + (size_t)(t + 1) * kstep;
            const char* a2 = last ? nA : cA + (size_t)(t + 2) * kstep; const char* b2 = last ? nB : cB + (size_t)(t + 2) * kstep;
            const char* a3 = a2 + kstep; const char* b3 = b2 + kstep;
            if (last && has_next) S.a_ready(nxt);
            if constexpr (SP2) {
            PG8_LDB(B0, 0, 0); PG8_LDB(B1, 0, 1); PG8_SCHED; PG8_LDA(At, 0, 0); PG8_STAGE(PG8_SA(1, 1), a1 + hstepA, voffA);
            PG8_WAIT_V(8); PG8_WAIT_L(0); PG8_BAR; PG8_MMA(0, 0, At, B0); PG8_MMA(0, 1, At, B1); PG8_BAR; PG8_SCHED;
            PG8_LDA(At, 0, 1); PG8_STAGE(PG8_SB(0, 0), b2, voffB); PG8_STAGE(PG8_SB(0, 1), b2 + hstepB, voffB); PG8_STAGE(PG8_SA(0, 0), a2, voffA);
            PG8_WAIT_V(8); PG8_WAIT_L(0); PG8_BAR; PG8_MMA(1, 0, At, B0); PG8_MMA(1, 1, At, B1); PG8_BAR; PG8_SCHED;
            PG8_LDB(B0, 1, 0); PG8_LDB(B1, 1, 1); PG8_SCHED; PG8_LDA(At, 1, 0); PG8_STAGE(PG8_SA(0, 1), a2 + hstepA, voffA);
            PG8_WAIT_V(8); PG8_WAIT_L(0); PG8_BAR; PG8_MMA(0, 0, At, B0); PG8_MMA(0, 1, At, B1); PG8_BAR; PG8_SCHED;
            PG8_LDA(At, 1, 1); PG8_STAGE(PG8_SB(1, 0), b3, voffB); PG8_STAGE(PG8_SB(1, 1), b3 + hstepB, voffB); PG8_STAGE(PG8_SA(1, 0), a3, voffA);
            PG8_WAIT_V(8); PG8_WAIT_L(0); PG8_BAR; PG8_MMA(1, 0, At, B0); PG8_MMA(1, 1, At, B1); PG8_BAR; PG8_SCHED;
            } else {
            PG8_LDB(B0, 0, 0); PG8_SCHED; PG8_LDA(At, 0, 0); PG8_STAGE(PG8_SA(1, 1), a1 + hstepA, voffA);
            PG8_WAIT_L(8); PG8_BAR; PG8_WAIT_L(0); PG8_MMA(0, 0, At, B0); PG8_BAR; PG8_SCHED;
            PG8_LDB(B1, 0, 1); PG8_STAGE(PG8_SB(0, 0), b2, voffB);
            PG8_BAR; PG8_WAIT_L(0); PG8_MMA(0, 1, At, B1); PG8_BAR;
            PG8_LDA(At, 0, 1); PG8_STAGE(PG8_SA(0, 0), a2, voffA);
            PG8_BAR; PG8_WAIT_L(0); PG8_MMA(1, 0, At, B0); PG8_BAR; PG8_SCHED;
            PG8_STAGE(PG8_SB(0, 1), b2 + hstepB, voffB);
            PG8_WAIT_V(6); PG8_BAR; PG8_MMA(1, 1, At, B1); PG8_BAR;
            PG8_LDB(B0, 1, 0); PG8_SCHED; PG8_LDA(At, 1, 0); PG8_STAGE(PG8_SA(0, 1), a2 + hstepA, voffA);
            PG8_WAIT_L(8); PG8_BAR; PG8_WAIT_L(0); PG8_MMA(0, 0, At, B0); PG8_BAR; PG8_SCHED;
            PG8_LDB(B1, 1, 1); PG8_STAGE(PG8_SB(1, 0), b3, voffB);
            PG8_BAR; PG8_WAIT_L(0); PG8_MMA(0, 1, At, B1); PG8_BAR;
            PG8_LDA(At, 1, 1); PG8_STAGE(PG8_SA(1, 0), a3, voffA);
            PG8_BAR; PG8_WAIT_L(0); PG8_MMA(1, 0, At, B0); PG8_BAR; PG8_SCHED;
            PG8_STAGE(PG8_SB(1, 1), b3 + hstepB, voffB);
            PG8_WAIT_V(6); PG8_BAR; PG8_MMA(1, 1, At, B1); PG8_BAR;
            }
        }
        if constexpr (ALIGN_EPI) { if (wr == 0) PG8_BAR; }
        if constexpr (!Epi::AFTER_DRAIN) { E(acc, cur, wr, wc, fr, fq); S.done(cur); }
        if (!has_next) break;
#pragma unroll
        for (int a = 0; a < 2; ++a)
#pragma unroll
            for (int b = 0; b < 2; ++b)
#pragma unroll
                for (int m = 0; m < 4; ++m)
#pragma unroll
                    for (int n = 0; n < 2; ++n) acc[a][b][m][n] = (f32x4){0.f, 0.f, 0.f, 0.f};
        cur = nxt; cA = nA; cB = nB; ++ui;
        if constexpr (ALIGN_EPI) { if (wr == 1) PG8_BAR; }
    }
    PG8_WAIT_V(0);
    if constexpr (!ALIGN_EPI) { if (wr == 0) PG8_BAR; }
    PG8_BAR;
    if constexpr (Epi::AFTER_DRAIN) { E.fused(acc, cur, wr, wc, fr, fq, lds, wid, lane); S.done(cur); }
#undef PG8_SA
#undef PG8_SB
#undef PG8_STAGE
#undef PG8_LDA
#undef PG8_LDB
#undef PG8_MMA
#undef PG8_WAIT_V
#undef PG8_WAIT_L
#undef PG8_BAR
#undef PG8_SCHED
}
}

constexpr int NWAVES = 8, NTHREADS = NWAVES * 64;
constexpr int BATCH = 2, SEQ = 8192, DM = 2048, MTOK = BATCH * SEQ;
constexpr int EVEN_IN = 3904, EVEN_INP = 4096, ODD_IN = 6144;
constexpr int NEXP = 16384;
constexpr float LN_EPS = 1e-5f;
constexpr float DN_ALPHA = 1.4142135623730951f;
constexpr float LOG2E = 1.4426950408889634f;

constexpr size_t MiB = 1u << 20;
constexpr size_t WS_CTL = 0, CTL_ZERO_BYTES = 1 * MiB;
constexpr size_t WS_WIN0 = 2 * MiB, WS_WQB = 18 * MiB, WS_WKVB = 20 * MiB, WS_WOUT0 = 22 * MiB, WS_WIN1 = 30 * MiB, WS_WOUT1 = 54 * MiB, WS_WPQ = 62 * MiB  , WS_KB = 78 * MiB  ;
constexpr size_t WS_T128 = 80 * MiB, WS_T64 = 84 * MiB, WS_SSQ = 86 * MiB, WS_IDX = 88 * MiB, WS_G = 96 * MiB;
constexpr size_t WS_QS = 87 * MiB;
constexpr size_t WS_UV = 104 * MiB;
constexpr size_t WS_XB = 360 * MiB;
constexpr size_t WS_XF = 424 * MiB;
constexpr size_t WS_A = 552 * MiB;
constexpr size_t WS_B = 744 * MiB;
constexpr size_t WS_C = 872 * MiB;
constexpr size_t WS_WS = 936 * MiB;
constexpr size_t WS_W8IN1 = 952 * MiB;
constexpr size_t WS_X8 = 968 * MiB;
constexpr size_t WS_END = 1000 * MiB;
constexpr int CW_BAR = 4096;

constexpr int RING_BYTES = 147456;
constexpr int MISC_OFF = RING_BYTES;
constexpr int LDS_BYTES = 151552;

#define GAS __attribute__((address_space(1)))
#define LAS __attribute__((address_space(3)))
#define DI __device__ __forceinline__
typedef unsigned short bf16;
typedef unsigned u32x4 __attribute__((ext_vector_type(4)));
typedef unsigned u32x2 __attribute__((ext_vector_type(2)));
typedef float f32x4 __attribute__((ext_vector_type(4)));
typedef float f32x2 __attribute__((ext_vector_type(2)));
typedef float f32x16 __attribute__((ext_vector_type(16)));
typedef short bf16x8 __attribute__((ext_vector_type(8)));
typedef short s16x4 __attribute__((ext_vector_type(4)));
typedef __bf16 bfx2 __attribute__((ext_vector_type(2)));
#define LDS_WAIT() asm volatile("s_waitcnt lgkmcnt(0)" ::: "memory")

DI unsigned f2bf(float f) { unsigned u = __builtin_bit_cast(unsigned, f); return (u + 0x7fffu + ((u >> 16) & 1u)) >> 16; }
DI unsigned pk2(float lo, float hi) { return f2bf(lo) | (f2bf(hi) << 16); }
DI unsigned cvtpk(float lo, float hi) { f32x2 v = {lo, hi}; bfx2 b = __builtin_convertvector(v, bfx2); return __builtin_bit_cast(unsigned, b); }
DI float bflo(unsigned w) { return __builtin_bit_cast(float, w << 16); }
DI float bfhi(unsigned w) { return __builtin_bit_cast(float, w & 0xffff0000u); }

template <int CTRL> DI int dpp_i(int v) { return __builtin_amdgcn_update_dpp(v, v, CTRL, 0xF, 0xF, true); }
DI float wave_sum(float v) {
    v += __builtin_bit_cast(float, dpp_i<0xB1>(__builtin_bit_cast(int, v)));
    v += __builtin_bit_cast(float, dpp_i<0x4E>(__builtin_bit_cast(int, v)));
    v += __builtin_bit_cast(float, dpp_i<0x141>(__builtin_bit_cast(int, v)));
    v += __builtin_bit_cast(float, dpp_i<0x140>(__builtin_bit_cast(int, v)));
    const int i = __builtin_bit_cast(int, v);
    return (__builtin_bit_cast(float, __builtin_amdgcn_readlane(i, 0)) + __builtin_bit_cast(float, __builtin_amdgcn_readlane(i, 16))) +
           (__builtin_bit_cast(float, __builtin_amdgcn_readlane(i, 32)) + __builtin_bit_cast(float, __builtin_amdgcn_readlane(i, 48)));
}
DI unsigned umax2(unsigned a, unsigned b) { return a > b ? a : b; }
DI unsigned wave_umax(unsigned v) {
    v = umax2(v, (unsigned)dpp_i<0xB1>((int)v));
    v = umax2(v, (unsigned)dpp_i<0x4E>((int)v));
    v = umax2(v, (unsigned)dpp_i<0x141>((int)v));
    v = umax2(v, (unsigned)dpp_i<0x140>((int)v));
    const unsigned a = (unsigned)__builtin_amdgcn_readlane((int)v, 0), b = (unsigned)__builtin_amdgcn_readlane((int)v, 16);
    const unsigned c = (unsigned)__builtin_amdgcn_readlane((int)v, 32), d = (unsigned)__builtin_amdgcn_readlane((int)v, 48);
    return umax2(umax2(a, b), umax2(c, d));
}
DI float rdlane_f(float v, int l) { return __builtin_bit_cast(float, __builtin_amdgcn_readlane(__builtin_bit_cast(int, v), l)); }
DI void xhalf(float x, float& lo, float& hi) { const unsigned u = __builtin_bit_cast(unsigned, x); const auto r = __builtin_amdgcn_permlane32_swap(u, u, false, false); const unsigned r0 = (unsigned)r[0], r1 = (unsigned)r[1];     lo = __builtin_bit_cast(float, r0); hi = __builtin_bit_cast(float, r1); }

#define XB_TMO      128
#define XB_XCNT(j)  (256  + 64 * (j))
#define XB_XSUB(j)  (1280 + 64 * (j))
#define XB_XGEN(j)  (2304 + 64 * (j))
#define XB_TOP      3328
#define XB_TOPGEN   3392
#define XCD_BAR_WORDS 3456
#define XB_SPIN_CAP (1u << 18)

__device__ __forceinline__ unsigned xb_ld(unsigned* p)              { return __hip_atomic_load(p, __ATOMIC_RELAXED, __HIP_MEMORY_SCOPE_AGENT); }
__device__ __forceinline__ unsigned xb_add(unsigned* p, unsigned v) { return __hip_atomic_fetch_add(p, v, __ATOMIC_RELAXED, __HIP_MEMORY_SCOPE_AGENT); }
__device__ __forceinline__ unsigned xb_xcc_id() { return (unsigned)__builtin_amdgcn_s_getreg((3 << 11) | 20) & 0xFu; }
#define XB_SPIN(cond, bar) do { unsigned _sp = 0; while (cond) { __builtin_amdgcn_s_sleep(1); \
    if ((++_sp & 255u) == 0u) { if (xb_ld(&(bar)[XB_TMO])) break; if (_sp > XB_SPIN_CAP) { atomicAdd(&(bar)[XB_TMO], 1u); break; } } } } while (0)

struct XcdBarrier {
    unsigned* bar; unsigned x;
    volatile LAS unsigned* st;
};

__device__ __forceinline__ XcdBarrier xcd_barrier_post(unsigned* bar, volatile LAS unsigned* st) {
    XcdBarrier b; b.bar = bar; b.x = xb_xcc_id(); b.st = st;
    if (threadIdx.x == 0) (void)xb_add(&bar[XB_XCNT(b.x)], 1u);
    return b;
}
__device__ __forceinline__ void xcd_barrier_complete(unsigned* bar, unsigned x, unsigned& nloc, unsigned& nx) {
    const unsigned G = gridDim.x * gridDim.y * gridDim.z;
    unsigned sum, cnt, mine, sp = 0u;
    for (;;) {
        sum = 0u; cnt = 0u; mine = 0u;
#pragma unroll
        for (unsigned j = 0; j < 16; ++j) { const unsigned c = xb_ld(&bar[XB_XCNT(j)]); sum += c; cnt += (c > 0u) ? 1u : 0u; mine = (j == x) ? c : mine; }
        if (sum == G) break;
        __builtin_amdgcn_s_sleep(1);
        if ((++sp & 255u) == 0u) { if (xb_ld(&bar[XB_TMO])) break; if (sp > XB_SPIN_CAP) { atomicAdd(&bar[XB_TMO], 1u); break; } }
    }
    nloc = mine > 0u ? mine : 1u; nx = cnt > 0u ? cnt : 1u;
}

__device__ __forceinline__ void xcd_barrier(const XcdBarrier& b) {
    asm volatile("s_waitcnt vmcnt(0)" ::: "memory");
    __syncthreads();
    if (threadIdx.x == 0) {
        unsigned* bar = b.bar;
        __builtin_amdgcn_s_waitcnt(0);
        unsigned nloc = b.st[0], nx = b.st[1];
        if (nloc == 0u) { xcd_barrier_complete(bar, b.x, nloc, nx); b.st[0] = nloc; b.st[1] = nx; }
        const unsigned old = xb_add(&bar[XB_XSUB(b.x)], 1u);
        const unsigned gen = old / nloc;
        if (old + 1u == (gen + 1u) * nloc) {
            __builtin_amdgcn_fence(__ATOMIC_RELEASE, "agent");
            asm volatile("s_waitcnt vmcnt(0)" ::: "memory");
            const unsigned og = xb_add(&bar[XB_TOP], 1u);
            const unsigned tg = og / nx;
            if (og + 1u == (tg + 1u) * nx) xb_add(&bar[XB_TOPGEN], 1u);
            else XB_SPIN(xb_ld(&bar[XB_TOPGEN]) == tg, bar);
            __builtin_amdgcn_fence(__ATOMIC_ACQUIRE, "agent");
            xb_add(&bar[XB_XGEN(b.x)], 1u);
            asm volatile("s_waitcnt vmcnt(0)" ::: "memory");
        } else {
            XB_SPIN(xb_ld(&bar[XB_XGEN(b.x)]) == gen, bar);
            __builtin_amdgcn_fence(__ATOMIC_ACQUIRE, "agent");
            asm volatile("s_waitcnt vmcnt(0)" ::: "memory");
        }
    }
    __syncthreads();
}

template <int MAP> DI int dest_row(int n) {
    if (MAP == 1) {
        if (n < 2048) { const int hh = n >> 7, w = n & 127; return hh * 128 + 2 * (w & 63) + (w >> 6); }
        if (n >= 3840) { const int j = n - 3840; return 3840 + 2 * (j & 31) + (j >> 5); }
        return n;
    }
    if (MAP == 2) { const int hh = n / 192, w = n - hh * 192; if (w < 128) return n; const int j = w - 128; return hh * 192 + 128 + 2 * (j & 31) + (j >> 5); }
    return n;
}
template <int MAP> DI void transpose_item(const float* __restrict__ W, int K, int N, bf16* WT, const float* __restrict__ gain, LAS float* scr, int item, int lane) {
    const int nblk = N / 32, kb = item / nblk, nb = item % nblk, k0 = 64 * kb, n0 = 32 * nb;
    float tv[32];
#pragma unroll
    for (int i = 0; i < 32; ++i) { const int kk = 2 * i + (lane >> 5); tv[i] = W[(size_t)(k0 + kk) * N + n0 + (lane & 31)]; }
    if (gain) {
#pragma unroll
        for (int i = 0; i < 32; ++i) tv[i] *= gain[k0 + 2 * i + (lane >> 5)]; }
#pragma unroll
    for (int i = 0; i < 32; ++i) { const int kk = 2 * i + (lane >> 5); scr[kk * 33 + (lane & 31)] = tv[i]; }
    LDS_WAIT();
    const int c = lane & 7;
#pragma unroll
    for (int j = 0; j < 4; ++j) { const int n = (lane >> 3) + 8 * j; const LAS float* s = scr + (8 * c) * 33 + n;
        u32x4 o; o.x = pk2(s[0 * 33], s[1 * 33]); o.y = pk2(s[2 * 33], s[3 * 33]); o.z = pk2(s[4 * 33], s[5 * 33]); o.w = pk2(s[6 * 33], s[7 * 33]);
        *(u32x4*)(WT + (size_t)dest_row<MAP>(n0 + n) * K + k0 + 8 * c) = o; }
    LDS_WAIT();
}
template <int MAP> DI void transpose_item_fp8(const float* __restrict__ W, int K, int N, unsigned char* WT, float mul, LAS float* scr, int item, int lane) {
    const int nblk = N / 64, kb = item / nblk, nb = item % nblk, k0 = 64 * kb, n0 = 64 * nb;
    f32x4 tv[16];
#pragma unroll
    for (int i = 0; i < 16; ++i) tv[i] = __builtin_nontemporal_load((const f32x4*)(W + (size_t)(k0 + 4 * i + (lane >> 4)) * N + n0 + 4 * (lane & 15)));
#pragma unroll
    for (int i = 0; i < 16; ++i) *(LAS f32x4*)(scr + (4 * i + (lane >> 4)) * 68 + 4 * (lane & 15)) = tv[i] * mul;
    LDS_WAIT();
    const LAS float* sp = scr + lane;
    unsigned char* dst = WT + (size_t)dest_row<MAP>(n0 + lane) * K + k0;
#pragma unroll
    for (int q4 = 0; q4 < 4; ++q4) { unsigned ow[4];
#pragma unroll
        for (int q = 0; q < 4; ++q) { const LAS float* p = sp + (16 * q4 + 4 * q) * 68;
            int w = 0; w = __builtin_amdgcn_cvt_pk_bf8_f32(p[0 * 68], p[1 * 68], w, false); w = __builtin_amdgcn_cvt_pk_bf8_f32(p[2 * 68], p[3 * 68], w, true); ow[q] = (unsigned)w; }
        *(u32x4*)(dst + 16 * q4) = (u32x4){ow[0], ow[1], ow[2], ow[3]}; }
    LDS_WAIT();
}
DI void convert_flat(const float* __restrict__ src, bf16* dst, size_t n, int gw, int NGW, int lane) {
    const size_t nit = n / 512;
    for (size_t it = gw; it < nit; it += (size_t)4 * NGW) {
        f32x4 a[4], b[4]; size_t e[4];
#pragma unroll
        for (int u = 0; u < 4; ++u) { size_t iu = it + (size_t)u * NGW; if (iu >= nit) iu = it; e[u] = iu * 512 + (size_t)lane * 8; a[u] = *(const f32x4*)(src + e[u]); b[u] = *(const f32x4*)(src + e[u] + 4); }
#pragma unroll
        for (int u = 0; u < 4; ++u) { u32x4 o; o.x = pk2(a[u][0], a[u][1]); o.y = pk2(a[u][2], a[u][3]); o.z = pk2(b[u][0], b[u][1]); o.w = pk2(b[u][2], b[u][3]);
            *(u32x4*)(dst + e[u]) = o; }
    }
}
DI unsigned fp6_code(float v) {
    const float a = fminf(fabsf(v), 7.5f);
    const int e = a >= 4.f ? 2 : (a >= 2.f ? 1 : 0);
    const float sc = e == 2 ? 2.f : (e == 1 ? 4.f : 8.f);
    int code = 8 * e + (int)rintf(a * sc); code = code > 31 ? 31 : code;
    return (v < 0.f ? 32u : 0u) | (unsigned)code;
}
DI unsigned fp4_code(float v) {
    const float a = fabsf(v);
    const unsigned c = (a > 0.25f) + (a > 0.75f) + (a > 1.25f) + (a > 1.75f) + (a > 2.5f) + (a > 3.5f) + (a > 5.0f);
    return (v < 0.f ? 8u : 0u) | c;
}
#ifndef U_FP4
#define U_FP4 1
#endif
#ifndef FP4_HI_FIRST
#define FP4_HI_FIRST 0
#endif
struct ProArgs {
    const float *x, *a_w_in, *b_q_norm, *b_w_q_b, *b_kv_norm, *b_w_kv_b, *ab_w_out, *c_w_in, *c_w_out, *peer_w_query, *peer_sub_keys, *peer_u, *peer_v;
    unsigned char* ws;
};
DI void prologue(const ProArgs& a, LAS unsigned char* lds, int gw, int NGW, int wave, int lane_in) {
    int lane = lane_in; asm volatile("" : "+v"(lane));
    LAS float* scr = (LAS float*)(lds + wave * 17408);
    unsigned char* ws = a.ws;
    constexpr int I_IN0 = (DM / 64) * (EVEN_IN / 64), I_QB = (512 / 64) * (1536 / 32), I_KVB = (256 / 64) * (2048 / 32), I_SQ = (DM / 64) * (DM / 64), I_IN1 = (DM / 64) * (ODD_IN / 64);
    constexpr int NITEMS = I_IN0 + I_QB + I_KVB + I_SQ + I_IN1 + I_SQ;
    for (int it = gw; it < NITEMS; it += NGW) {
        int r = it;
        if (r < I_IN0) { transpose_item_fp8<1>(a.a_w_in, DM, EVEN_IN, ws + WS_WIN0, 1.0f, scr, r, lane); continue; } r -= I_IN0;
        if (r < I_QB) { transpose_item<2>(a.b_w_q_b, 512, 1536, (bf16*)(ws + WS_WQB), a.b_q_norm, scr, r, lane); continue; } r -= I_QB;
        if (r < I_KVB) { transpose_item<0>(a.b_w_kv_b, 256, 2048, (bf16*)(ws + WS_WKVB), a.b_kv_norm, scr, r, lane); continue; } r -= I_KVB;
        if (r < I_SQ) { transpose_item_fp8<0>(a.ab_w_out, DM, DM, ws + WS_WOUT0, 1.0f, scr, r, lane); continue; } r -= I_SQ;
        if (r < I_IN1) { transpose_item_fp8<0>(a.c_w_in, DM, ODD_IN, ws + WS_W8IN1, 1.0f, scr, r, lane); continue; } r -= I_IN1;
        transpose_item_fp8<0>(a.c_w_out, DM, DM, ws + WS_WOUT1, 1.0f, scr, r, lane);
    }
    convert_flat(a.peer_w_query, (bf16*)(ws + WS_WPQ), (size_t)2 * DM * DM, gw, NGW, lane);
    { unsigned char* wz = ws + WS_WIN0 + (size_t)EVEN_IN * DM; const size_t nz = (size_t)(EVEN_INP - EVEN_IN) * DM / 16;
      for (size_t i = (size_t)gw * 64 + lane; i < nz; i += (size_t)NGW * 64) *(u32x4*)(wz + i * 16) = (u32x4){0u, 0u, 0u, 0u}; }
    { bf16* kb = (bf16*)(ws + WS_KB);
      for (size_t i = (size_t)gw * 64 + lane; i < (size_t)2 * 2048 * 256 / 8; i += (size_t)NGW * 64) {
          const size_t e = i * 8; const int layer = (int)(e / (2048 * 256)); const int rem = (int)(e % (2048 * 256)); const int n = rem >> 8, k = rem & 255;
          const int h = n >> 8, p = (n >> 7) & 1, nn = n & 127, pp = k >> 7, kk = k & 127;
          u32x4 o = (u32x4){0u, 0u, 0u, 0u};
          if (p == pp) { const float* s = a.peer_sub_keys + ((((size_t)layer * 8 + h) * 2 + p) * 128 + nn) * 128 + kk; const f32x4 u = *(const f32x4*)s, v = *(const f32x4*)(s + 4);
              o.x = pk2(u[0], u[1]); o.y = pk2(u[2], u[3]); o.z = pk2(v[0], v[1]); o.w = pk2(v[2], v[3]); }
          *(u32x4*)(kb + e) = o; } }
    { float* t128 = (float*)(ws + WS_T128); float* t64 = (float*)(ws + WS_T64);
      for (int i = gw * 64 + lane; i < SEQ * 96; i += NGW * 64) {
          const int pos = i / 96, j = i % 96; const bool big = j < 64; const int idx = big ? j : j - 64; const float half = big ? 64.f : 32.f;
          const float inv = powf(10000.0f, -(float)idx / half); const float ang = (float)pos * inv;
          const float c = cosf(ang), s = sinf(ang);
          float* d = big ? t128 + ((size_t)pos * 64 + idx) * 2 : t64 + ((size_t)pos * 32 + idx) * 2; d[0] = c; d[1] = s; } }
    {
#define QLOAD(dst, r_) do { const int tb_ = (r_) / NEXP, er_ = (r_) % NEXP; const float* src_ = ((tb_ & 1) ? a.peer_v : a.peer_u) + ((size_t)(tb_ >> 1) * NEXP + er_) * DM + 4 * lane; \
          _Pragma("unroll") for (int qq_ = 0; qq_ < 8; ++qq_) (dst)[qq_] = __builtin_nontemporal_load((const f32x4*)(src_ + 256 * qq_)); } while (0)
      int row = gw; f32x4 v[8], vn[8];
      if (row < 4 * NEXP) QLOAD(v, row);
      while (row < 4 * NEXP) {
          const int nrow = row + NGW;
          if (nrow < 4 * NEXP) QLOAD(vn, nrow);
          float am = 0.f;
#pragma unroll
          for (int qq = 0; qq < 8; ++qq) am = fmaxf(am, fmaxf(fmaxf(fabsf(v[qq][0]), fabsf(v[qq][1])), fmaxf(fabsf(v[qq][2]), fabsf(v[qq][3]))));
          const float amax = __builtin_bit_cast(float, wave_umax(__builtin_bit_cast(unsigned, am)));
          const bool isv = U_FP4 ? true : ((row / NEXP) & 1) != 0;
          const float top = isv ? 6.0f : 7.5f;
          const float inv = amax > 0.f ? top / amax : 1.0f;
          if (lane == 0) ((float*)(ws + WS_QS))[row] = amax > 0.f ? amax / top : 1.0f;
          if (isv) {
              unsigned wq[4] = {0u, 0u, 0u, 0u};
#pragma unroll
              for (int d = 0; d < 4; ++d) {
                  unsigned w = 0u; const f32x4 lo = v[2 * d] * inv, hi = v[2 * d + 1] * inv;
                  w = __builtin_amdgcn_cvt_scalef32_pk_fp4_f32(w, lo[0], lo[1], 1.0f, 0); w = __builtin_amdgcn_cvt_scalef32_pk_fp4_f32(w, lo[2], lo[3], 1.0f, 1);
                  w = __builtin_amdgcn_cvt_scalef32_pk_fp4_f32(w, hi[0], hi[1], 1.0f, 2); w = __builtin_amdgcn_cvt_scalef32_pk_fp4_f32(w, hi[2], hi[3], 1.0f, 3);
                  wq[d] = w; }
              unsigned char* dstv = ws + WS_UV + (size_t)(row / NEXP) * 24 * MiB + (size_t)(row % NEXP) * 1024;
              *(u32x4*)(dstv + 16 * lane) = (u32x4){wq[0], wq[1], wq[2], wq[3]};
          } else {
          unsigned long long w0 = 0ull, w1 = 0ull, w2 = 0ull;
#pragma unroll
          for (int j = 0; j < 32; ++j) { const unsigned long long cde = (unsigned long long)fp6_code(v[j >> 2][j & 3] * inv); const int pos = 6 * j;
              if (pos < 64) { w0 |= cde << pos; if (pos + 6 > 64) w1 |= cde >> (64 - pos); }
              else if (pos < 128) { w1 |= cde << (pos - 64); if (pos + 6 > 128) w2 |= cde >> (128 - pos); }
              else w2 |= cde << (pos - 128); }
          unsigned char* dst = ws + WS_UV + (size_t)row * 1536;
          *(u32x4*)(dst + 16 * lane) = (u32x4){(unsigned)w0, (unsigned)(w0 >> 32), (unsigned)w1, (unsigned)(w1 >> 32)};
          *(u32x2*)(dst + 1024 + 8 * lane) = (u32x2){(unsigned)w2, (unsigned)(w2 >> 32)};
          }
#pragma unroll
          for (int qq = 0; qq < 8; ++qq) v[qq] = vn[qq];
          row = nrow;
      }
#undef QLOAD
    }
    { const size_t nit = (size_t)MTOK * DM / 512; bf16* dstb = (bf16*)(ws + WS_XB); unsigned char* dst8 = ws + WS_X8;
      for (size_t it = gw; it < nit; it += (size_t)8 * NGW) {
          f32x4 p[8], q[8]; size_t e[8];
#pragma unroll
          for (int u = 0; u < 8; ++u) { size_t iu = it + (size_t)u * NGW; if (iu >= nit) iu = it; e[u] = iu * 512 + (size_t)lane * 8; p[u] = __builtin_nontemporal_load((const f32x4*)(a.x + e[u])); q[u] = __builtin_nontemporal_load((const f32x4*)(a.x + e[u] + 4)); }
#pragma unroll
          for (int u = 0; u < 8; ++u) {
              u32x4 o; o.x = pk2(p[u][0], p[u][1]); o.y = pk2(p[u][2], p[u][3]); o.z = pk2(q[u][0], q[u][1]); o.w = pk2(q[u][2], q[u][3]);
              *(u32x4*)(dstb + e[u]) = o;
              int w0 = 0, w1 = 0; w0 = __builtin_amdgcn_cvt_pk_fp8_f32(p[u][0], p[u][1], w0, false); w0 = __builtin_amdgcn_cvt_pk_fp8_f32(p[u][2], p[u][3], w0, true);
              w1 = __builtin_amdgcn_cvt_pk_fp8_f32(q[u][0], q[u][1], w1, false); w1 = __builtin_amdgcn_cvt_pk_fp8_f32(q[u][2], q[u][3], w1, true);
              *(u32x2*)(dst8 + e[u]) = (u32x2){(unsigned)w0, (unsigned)w1}; } } }
}


namespace att {
#define MFMA32(a, b, c) __builtin_amdgcn_mfma_f32_32x32x16_bf16((a), (b), (c), 0, 0, 0)
typedef short v4i16_t __attribute__((ext_vector_type(4)));
DI int crow(int i, int hh) { return (i & 3) + 8 * (i >> 2) + 4 * hh; }
DI unsigned off_b(unsigned row, unsigned ch) { return 256u * row + 16u * (ch ^ (((row & 3u) << 2) | ((row >> 2) & 3u))); }
DI s16x4 vtr(LAS const unsigned char* p) { return __builtin_bit_cast(s16x4, __builtin_amdgcn_ds_read_tr16_b64_v4i16((LAS v4i16_t*)p)); }

constexpr int QK_DEPTH = 6, PV_DEPTH = 4;
template <int NS, int NBLK, int KP, int DEPTH = QK_DEPTH>
DI void qk_tile(f32x16 (&x)[NBLK], const bf16x8 (&qf)[NS], LAS const unsigned char* kimg, int r, int hh) {
    constexpr int N = NS * NBLK, D = N < DEPTH ? N : DEPTH;
    bf16x8 a[N];
#pragma unroll
    for (int i = 0; i < N; ++i) { const int s = i / NBLK, b = i % NBLK;
        const unsigned o = KP ? (unsigned)((32 * b + r) * KP + (2 * s + hh) * 16) : off_b((unsigned)(32 * b + r), (unsigned)(2 * s + hh));
        a[i] = *(LAS const bf16x8*)(kimg + o); }
#pragma unroll
    for (int b = 0; b < NBLK; ++b)
#pragma unroll
        for (int i = 0; i < 16; ++i) x[b][i] = 0.f;
#pragma unroll
    for (int i = 0; i < N; ++i) { const int s = i / NBLK, b = i % NBLK; x[b] = MFMA32(a[i], qf[s], x[b]); }
    __builtin_amdgcn_sched_group_barrier(0x100, D, 0);
#pragma unroll
    for (int i = 0; i < N - D; ++i) { __builtin_amdgcn_sched_group_barrier(0x008, 1, 0); __builtin_amdgcn_sched_group_barrier(0x100, 1, 0); }
    __builtin_amdgcn_sched_group_barrier(0x008, D, 0);
}
template <int NBLK>
DI void pv_tile(f32x16 (&o)[4], const f32x16 (&p)[NBLK], LAS const unsigned char* vimg, int lane) {
    const unsigned hh = lane >> 5, blkL = (lane >> 4) & 1, q = (lane & 15) >> 2, pp = lane & 3;
    constexpr int N = NBLK * 8, D = PV_DEPTH;
    bf16x8 vf[N], pf[NBLK * 2];
#pragma unroll
    for (int b = 0; b < NBLK; ++b)
#pragma unroll
        for (int s2 = 0; s2 < 2; ++s2) {
            u32x4 pw;
            pw.x = cvtpk(p[b][8 * s2 + 0], p[b][8 * s2 + 1]); pw.y = cvtpk(p[b][8 * s2 + 2], p[b][8 * s2 + 3]);
            pw.z = cvtpk(p[b][8 * s2 + 4], p[b][8 * s2 + 5]); pw.w = cvtpk(p[b][8 * s2 + 6], p[b][8 * s2 + 7]);
            pf[2 * b + s2] = __builtin_bit_cast(bf16x8, pw);
            const unsigned R0 = 32u * b + 16u * s2 + 4u * hh;
#pragma unroll
            for (int c = 0; c < 4; ++c) {
                const unsigned ch = 4u * c + 2u * blkL + (pp >> 1);
                const s16x4 lo = vtr(vimg + off_b(R0 + q, ch) + 8u * (pp & 1));
                const s16x4 hi = vtr(vimg + off_b(R0 + 8u + q, ch) + 8u * (pp & 1));
                vf[(2 * b + s2) * 4 + c] = __builtin_shufflevector(lo, hi, 0, 1, 2, 3, 4, 5, 6, 7);
            }
        }
#pragma unroll
    for (int i = 0; i < N; ++i) o[i & 3] = MFMA32(vf[i], pf[i >> 2], o[i & 3]);
    __builtin_amdgcn_sched_group_barrier(0x100, 2 * D, 0);
#pragma unroll
    for (int i = 0; i < N - D; ++i) { __builtin_amdgcn_sched_group_barrier(0x008, 1, 0); __builtin_amdgcn_sched_group_barrier(0x100, 2, 0); }
    __builtin_amdgcn_sched_group_barrier(0x008, D, 0);
}
template <int NBLK, bool SEL, class Valid>
DI void softmax_step(f32x16 (&x)[NBLK], f32x16 (&o)[4], float& m, float& l, float sc, bool need_mask, const Valid& valid) {
    if (need_mask) {
#pragma unroll
        for (int b = 0; b < NBLK; ++b)
#pragma unroll
            for (int i = 0; i < 16; ++i) if (!valid(b, i)) x[b][i] = -1e30f;
    }
    float tmax = -1e30f;
#pragma unroll
    for (int b = 0; b < NBLK; ++b)
#pragma unroll
        for (int i = 0; i < 16; ++i) tmax = fmaxf(tmax, x[b][i]);
    { float tl_, th_; xhalf(tmax, tl_, th_); tmax = fmaxf(tl_, th_); }
    const bool keep = __all((tmax - m) * sc <= 8.0f);
    if (!keep) {
        const float mn = fmaxf(m, tmax);
        const float alpha = __builtin_amdgcn_exp2f((m - mn) * sc);
        l *= alpha; m = mn;
#pragma unroll
        for (int c = 0; c < 4; ++c)
#pragma unroll
            for (int i = 0; i < 16; ++i) o[c][i] *= alpha;
    }
    const float mb = m * sc;
    float ls = 0.f;
#pragma unroll
    for (int b = 0; b < NBLK; ++b)
#pragma unroll
        for (int i = 0; i < 16; ++i) { float p = __builtin_amdgcn_exp2f(x[b][i] * sc - mb); if (SEL) { if (need_mask) p = (x[b][i] <= -1e29f) ? 0.f : p; } x[b][i] = p; ls += p; }
    l += ls;
}
DI void store_o(const f32x16 (&o)[4], float inv, unsigned char* orow, int hh) {
#pragma unroll
    for (int c = 0; c < 4; ++c)
#pragma unroll
        for (int g = 0; g < 4; ++g) {
            int w = 0; w = __builtin_amdgcn_cvt_pk_fp8_f32(o[c][4 * g + 0] * inv, o[c][4 * g + 1] * inv, w, false); w = __builtin_amdgcn_cvt_pk_fp8_f32(o[c][4 * g + 2] * inv, o[c][4 * g + 3] * inv, w, true);
            *(int*)(orow + 32 * c + 8 * g + 4 * hh) = w;
        }
}

DI void pswap(unsigned& d, unsigned& s_) { const auto r = __builtin_amdgcn_permlane32_swap(d, s_, false, false); const unsigned r0 = (unsigned)r[0], r1 = (unsigned)r[1]; d = r0; s_ = r1; }
DI void store_o_wide(const f32x16 (&o)[4], float inv, unsigned char* orow, int hh) {
#pragma unroll
    for (int c = 0; c < 4; ++c) {
        unsigned w[4];
#pragma unroll
        for (int g = 0; g < 4; ++g) {
            int t = 0; t = __builtin_amdgcn_cvt_pk_fp8_f32(o[c][4 * g + 0] * inv, o[c][4 * g + 1] * inv, t, false); t = __builtin_amdgcn_cvt_pk_fp8_f32(o[c][4 * g + 2] * inv, o[c][4 * g + 3] * inv, t, true);
            w[g] = (unsigned)t; }
        pswap(w[0], w[1]); pswap(w[2], w[3]);
        pswap(w[0], w[2]); pswap(w[1], w[3]);
        *(u32x4*)(orow + 32 * c + 16 * hh) = (u32x4){w[0], w[1], w[2], w[3]};
    }
}

struct CausalValid { int kbase, qpos, hh; DI bool operator()(int b, int i) const { return kbase + 32 * b + crow(i, hh) <= qpos; } };
DI void mla_unit(LAS unsigned char* lds, int b, int h, int qb, const bf16* __restrict__ QM, const bf16* __restrict__ KVM, const bf16* __restrict__ H, unsigned char* ATT) {
    constexpr int KP = 400;
    LAS unsigned char* kimg = lds; LAS unsigned char* vimg = lds + 64 * KP;
    int tid_ = threadIdx.x; asm volatile("" : "+v"(tid_));
    const int tid = tid_, lane = tid & 63, r = lane & 31, hh = lane >> 5; const int wid = __builtin_amdgcn_readfirstlane(tid >> 6);
    const size_t rowbase = (size_t)b * SEQ; const int q0 = qb * 256, qw = q0 + wid * 32;
    bf16x8 qf[12];
    { const bf16* qp = QM + (rowbase + qw + r) * 1536 + h * 192 + hh * 8;
#pragma unroll
      for (int s = 0; s < 12; ++s) qf[s] = *(const bf16x8*)(qp + 16 * s); }
    f32x16 o[4];
#pragma unroll
    for (int c = 0; c < 4; ++c)
#pragma unroll
        for (int i = 0; i < 16; ++i) o[c][i] = 0.f;
    float m = -1e30f, l = 0.f;
    const float sc = 0.07216878364870322f * LOG2E;
    const int NT = (q0 + 256) / 64, wlast = (qw + 31) / 64;
    u32x4 kreg[3], vreg[2];
#define MLA_LOAD(kt) do { \
        _Pragma("unroll") for (int i_ = 0; i_ < 3; ++i_) { const int n_ = tid + 512 * i_, row_ = n_ / 24, ch_ = n_ - row_ * 24; const size_t key_ = rowbase + (size_t)(kt) * 64 + row_; \
            const bf16* s_ = ch_ < 16 ? KVM + key_ * 2048 + h * 256 + ch_ * 8 : H + key_ * 4096 + 3840 + (ch_ - 16) * 8; kreg[i_] = *(const u32x4*)s_; } \
        _Pragma("unroll") for (int i_ = 0; i_ < 2; ++i_) { const int n_ = tid + 512 * i_, row_ = n_ >> 4, ch_ = n_ & 15; const size_t key_ = rowbase + (size_t)(kt) * 64 + row_; \
            vreg[i_] = *(const u32x4*)(KVM + key_ * 2048 + h * 256 + 128 + ch_ * 8); } } while (0)
#define MLA_STORE() do { \
        _Pragma("unroll") for (int i_ = 0; i_ < 3; ++i_) { const int n_ = tid + 512 * i_, row_ = n_ / 24, ch_ = n_ - row_ * 24; *(LAS u32x4*)(kimg + row_ * KP + ch_ * 16) = kreg[i_]; } \
        _Pragma("unroll") for (int i_ = 0; i_ < 2; ++i_) { const int n_ = tid + 512 * i_, row_ = n_ >> 4, ch_ = n_ & 15; *(LAS u32x4*)(vimg + off_b((unsigned)row_, (unsigned)ch_)) = vreg[i_]; } } while (0)
    MLA_LOAD(0);
    for (int kt = 0; kt < NT; ++kt) {
        __syncthreads();
        MLA_STORE();
        __syncthreads();
        if (kt + 1 < NT) MLA_LOAD(kt + 1);
        if (kt <= wlast) {
            f32x16 x[2];
            qk_tile<12, 2, KP, 4>(x, qf, kimg, r, hh);
            const bool need_mask = (kt * 64 + 63 > qw);
            const CausalValid cv{kt * 64, qw + r, hh};
            softmax_step<2, false>(x, o, m, l, sc, need_mask, cv);
            pv_tile<2>(o, x, vimg, lane);
        }
    }
#undef MLA_LOAD
#undef MLA_STORE
    const float lt = l + __shfl_xor(l, 32);
    store_o(o, 1.0f / lt, ATT + (rowbase + qw + r) * 2048 + 1024 + h * 128, hh);
}

struct BandValid { int kbase, mq, hh; DI bool operator()(int b, int i) const { const int k = kbase + 32 * b + crow(i, hh); return k <= mq && k >= mq - 128; } };
DI void dilated_block_unit(LAS unsigned char* lds, int b, int h, int r16b, int mb, const bf16* __restrict__ H, unsigned char* ATT) {
    int tid_ = threadIdx.x; asm volatile("" : "+v"(tid_));
    const int tid = tid_, lane = tid & 63; const int wid = __builtin_amdgcn_readfirstlane(tid >> 6); const int r16 = r16b + wid;
    LAS unsigned char* wlds = lds + wid * 16384;
    LAS unsigned char* kimg = wlds; LAS unsigned char* vimg = wlds + 8192;
    const int r = lane & 31, hh = lane >> 5;
    const size_t rowbase = (size_t)b * SEQ;
    const int tq = r16 + 16 * (32 * mb + r);
    bf16x8 qf[8];
    { const bf16* qp = H + (rowbase + tq) * EVEN_INP + h * 128 + hh * 8;
#pragma unroll
      for (int s = 0; s < 8; ++s) qf[s] = *(const bf16x8*)(qp + 16 * s); }
    f32x16 o[4];
#pragma unroll
    for (int c = 0; c < 4; ++c)
#pragma unroll
        for (int i = 0; i < 16; ++i) o[c][i] = 0.f;
    float m = -1e30f, l = 0.f;
    const float sc = 0.08838834764831845f * LOG2E;
    const bf16* Kb = H + 1024 + h * 128; const bf16* Vb = H + 2048 + h * 128;
    {
        LAS unsigned char* ks = lds; LAS unsigned char* vs = lds + 16384;
        const int pmin = 512 * mb + r16, pmax = pmin + 496;
        int t0 = 512 * mb + r16b - 128; if (t0 < 0) t0 = 0;
        int tl = 512 * mb + r16b + 7 + 496; if (tl > SEQ - 1) tl = SEQ - 1;
        u32x4 kr2[2], vr2[2];
#define DL_LOAD(t_) do { _Pragma("unroll") for (int i_ = 0; i_ < 2; ++i_) { const int n_ = tid + 512 * i_, row_ = n_ >> 4, ch_ = n_ & 15; int pos_ = (t_) + row_; if (pos_ > SEQ - 1) pos_ = SEQ - 1; \
            const size_t off_ = (rowbase + pos_) * EVEN_INP + ch_ * 8; kr2[i_] = *(const u32x4*)(Kb + off_); vr2[i_] = *(const u32x4*)(Vb + off_); } } while (0)
#define DL_STORE() do { _Pragma("unroll") for (int i_ = 0; i_ < 2; ++i_) { const int n_ = tid + 512 * i_, row_ = n_ >> 4, ch_ = n_ & 15; const unsigned ob_ = off_b((unsigned)row_, (unsigned)ch_); \
            *(LAS u32x4*)(ks + ob_) = kr2[i_]; *(LAS u32x4*)(vs + ob_) = vr2[i_]; } } while (0)
        DL_LOAD(t0);
        for (int t = t0; t <= tl; t += 64) {
            __syncthreads();
            DL_STORE();
            __syncthreads();
            if (t + 64 <= tl) DL_LOAD(t + 64);
            if (t <= pmax && t + 63 >= pmin - 128) {
                f32x16 x[2];
                qk_tile<8, 2, 0>(x, qf, ks, r, hh);
                const BandValid bv{t, tq, hh};
                softmax_step<2, true>(x, o, m, l, sc, true, bv);
                pv_tile<2>(o, x, vs, lane);
            }
        }
#undef DL_LOAD
#undef DL_STORE
        __syncthreads();
    }
    for (int pi = 1; pi < 3; ++pi) {
        const int dsh = 2 * pi, d = 1 << dsh, rd = r16 & (d - 1), c0 = (r16 - rd) >> dsh, st = 16 >> dsh;
        const int mq = c0 + st * (32 * mb + r), mq0 = c0 + st * (32 * mb), mq31 = mq0 + st * 31;
        int ms = mq0 - 128; if (ms < 0) ms = 0;
        for (int mt = ms; mt <= mq31; mt += 32) {
            u32x4 kr[8], vr[8];
#pragma unroll
            for (int i = 0; i < 8; ++i) { const int n = lane + 64 * i, row = n >> 4, ch = n & 15; int pos = rd + ((mt + row) << dsh); if (pos > SEQ - 1) pos = SEQ - 1;
                const size_t off = (rowbase + pos) * EVEN_INP + ch * 8; kr[i] = *(const u32x4*)(Kb + off); vr[i] = *(const u32x4*)(Vb + off); }
#pragma unroll
            for (int i = 0; i < 8; ++i) { const int n = lane + 64 * i, row = n >> 4, ch = n & 15; const unsigned ob = off_b((unsigned)row, (unsigned)ch);
                *(LAS u32x4*)(kimg + ob) = kr[i]; *(LAS u32x4*)(vimg + ob) = vr[i]; }
            LDS_WAIT();
            f32x16 x[1];
            qk_tile<8, 1, 0>(x, qf, kimg, r, hh);
            const bool need_mask = !(mt + 31 <= mq0 && mt >= mq31 - 128);
            const BandValid bv{mt, mq, hh};
            softmax_step<1, true>(x, o, m, l, sc, need_mask, bv);
            pv_tile<1>(o, x, vimg, lane);
            LDS_WAIT();
        }
    }
    const float lt = l + __shfl_xor(l, 32);
    store_o_wide(o, 1.0f / lt, ATT + (rowbase + tq) * 2048 + h * 128, hh);
}

constexpr float SB_CUT = 48.0f;
DI void stick_unit(LAS unsigned char* lds, int b, int h, int qb, const bf16* __restrict__ H, unsigned char* ATT, bool early_exit) {
    constexpr int KP = 272;
    LAS unsigned char* kimg = lds; LAS unsigned char* vimg = lds + 64 * KP; LAS unsigned* flags = (LAS unsigned*)(lds + 64 * KP + 16384);
    int tid_ = threadIdx.x; asm volatile("" : "+v"(tid_));
    const int tid = tid_, lane = tid & 63, r = lane & 31, hh = lane >> 5; const int wid = __builtin_amdgcn_readfirstlane(tid >> 6);
    const size_t rowbase = (size_t)b * SEQ; const int q0 = qb * 256, qw = q0 + wid * 32;
    bf16x8 qf[8];
    { const bf16* qp = H + (rowbase + qw + r) * ODD_IN + h * 128 + hh * 8;
#pragma unroll
      for (int s = 0; s < 8; ++s) { const u32x4 qv = *(const u32x4*)(qp + 16 * s); u32x4 qs;
#pragma unroll
          for (int e = 0; e < 4; ++e) qs[e] = cvtpk(bflo(qv[e]) * (0.08838834764831845f * LOG2E), bfhi(qv[e]) * (0.08838834764831845f * LOG2E));
          qf[s] = __builtin_bit_cast(bf16x8, qs); } }
    f32x16 o[4];
#pragma unroll
    for (int c = 0; c < 4; ++c)
#pragma unroll
        for (int i = 0; i < 16; ++i) o[c][i] = 0.f;
    float R = 0.f;
    const int NT = (q0 + 256) / 64, wlast = (qw + 31) / 64;
    const bf16* Kb = H + 2048 + h * 128; const bf16* Vb = H + 4096 + h * 128;
    u32x4 kreg[2], vreg[2];
#define SB_LOAD(kt) do { _Pragma("unroll") for (int i_ = 0; i_ < 2; ++i_) { const int n_ = tid + 512 * i_, row_ = n_ >> 4, ch_ = n_ & 15; const size_t off_ = (rowbase + (size_t)(kt) * 64 + row_) * ODD_IN + ch_ * 8; \
            kreg[i_] = *(const u32x4*)(Kb + off_); vreg[i_] = *(const u32x4*)(Vb + off_); } } while (0)
#define SB_STORE() do { _Pragma("unroll") for (int i_ = 0; i_ < 2; ++i_) { const int n_ = tid + 512 * i_, row_ = n_ >> 4, ch_ = n_ & 15; \
            *(LAS u32x4*)(kimg + row_ * KP + ch_ * 16) = kreg[i_]; *(LAS u32x4*)(vimg + off_b((unsigned)row_, (unsigned)ch_)) = vreg[i_]; } } while (0)
    if (tid < 8) flags[tid] = 0u;
    bool wdone = false;
    SB_LOAD(NT - 1);
    for (int kt = NT - 1; kt >= 0; --kt) {
        __syncthreads();
        if (early_exit) { unsigned alld = 1u;
#pragma unroll
            for (int w = 0; w < 8; ++w) alld &= flags[w];
            if (alld) break; }
        SB_STORE();
        __syncthreads();
        if (kt > 0) SB_LOAD(kt - 1);
        if (kt <= wlast && !wdone) {
            f32x16 x[2];
            qk_tile<8, 2, KP>(x, qf, kimg, r, hh);
            const bool need_mask = (kt * 64 + 63 >= qw);
            const int qpos = qw + r, kbase = kt * 64;
            f32x16 y[2];
#pragma unroll
            for (int bb = 0; bb < 2; ++bb)
#pragma unroll
                for (int i = 0; i < 16; ++i) {
                    const float z = x[bb][i];
                    const float a = __builtin_amdgcn_logf(1.0f + __builtin_amdgcn_exp2f(-fabsf(z)));
                    float lb = -(fmaxf(-z, 0.f) + a), lr = -(fmaxf(z, 0.f) + a);
                    if (need_mask) { const bool ok = kbase + 32 * bb + crow(i, hh) < qpos; lb = ok ? lb : -1e30f; lr = ok ? lr : 0.f; }
                    x[bb][i] = lb; y[bb][i] = lr;
                }
            float G[8], Go[8], Ta[8];
#pragma unroll
            for (int gi = 0; gi < 8; ++gi) { const int bb = gi >> 2, i0 = 4 * (gi & 3); const float g_ = (y[bb][i0] + y[bb][i0 + 1]) + (y[bb][i0 + 2] + y[bb][i0 + 3]); float gl_, gh_; xhalf(g_, gl_, gh_); G[gi] = gl_ + gh_; Go[gi] = gh_; }
            float accs = 0.f;
#pragma unroll
            for (int gi = 7; gi >= 0; --gi) { Ta[gi] = accs + (hh == 0 ? Go[gi] : 0.f); accs += G[gi]; }
#pragma unroll
            for (int gi = 0; gi < 8; ++gi) { const int bb = gi >> 2, i0 = 4 * (gi & 3);
                const float base = R + Ta[gi];
                const float e3 = base, e2 = e3 + y[bb][i0 + 3], e1 = e2 + y[bb][i0 + 2], e0 = e1 + y[bb][i0 + 1];
                x[bb][i0 + 0] = __builtin_amdgcn_exp2f(x[bb][i0 + 0] + e0);
                x[bb][i0 + 1] = __builtin_amdgcn_exp2f(x[bb][i0 + 1] + e1);
                x[bb][i0 + 2] = __builtin_amdgcn_exp2f(x[bb][i0 + 2] + e2);
                x[bb][i0 + 3] = __builtin_amdgcn_exp2f(x[bb][i0 + 3] + e3); }
            R += accs;
            pv_tile<2>(o, x, vimg, lane);
        }
        if (early_exit) { const bool done = (kt <= wlast) ? (R < -SB_CUT * LOG2E) : false; const bool wd = __all(done) || kt == 0; wdone = wd; if (lane == 0) flags[wid] = wd ? 1u : 0u; }
    }
#undef SB_LOAD
#undef SB_STORE
    store_o_wide(o, 1.0f, ATT + (rowbase + qw + r) * 2048 + h * 128, hh);
    __syncthreads();
}
}


DI void ln_rows(const float* __restrict__ Y, const float* __restrict__ gain, const float* __restrict__ bias, float* XO, bf16* XOB, int gw, int NGW, int lane_in) {
    int lane = lane_in; asm volatile("" : "+v"(lane));
    for (int row = gw; row < MTOK; row += NGW) {
        const f32x4* yr = (const f32x4*)(Y + (size_t)row * DM) + lane;
        f32x4 v[8]; float s = 0.f;
#pragma unroll
        for (int j = 0; j < 8; ++j) { v[j] = yr[64 * j]; s += (v[j][0] + v[j][1]) + (v[j][2] + v[j][3]); }
        const float mean = wave_sum(s) * (1.0f / DM); float s2 = 0.f;
#pragma unroll
        for (int j = 0; j < 8; ++j) { v[j] = v[j] - mean; s2 += (v[j][0] * v[j][0] + v[j][1] * v[j][1]) + (v[j][2] * v[j][2] + v[j][3] * v[j][3]); }
        const float rstd = 1.0f / sqrtf(wave_sum(s2) * (1.0f / DM) + LN_EPS);
        f32x4* xo = (f32x4*)(XO + (size_t)row * DM) + lane; u32x2* xb = (u32x2*)(XOB + (size_t)row * DM) + lane;
#pragma unroll
        for (int j = 0; j < 8; ++j) { const f32x4 g = ((const f32x4*)gain)[lane + 64 * j], bb = ((const f32x4*)bias)[lane + 64 * j];
            const f32x4 y = v[j] * rstd * g + bb; if (XO) xo[64 * j] = y; u32x2 w; w.x = pk2(y[0], y[1]); w.y = pk2(y[2], y[3]); xb[64 * j] = w; }
    }
}

DI void ln_rows_b(const bf16* __restrict__ Y, const float* __restrict__ gain, const float* __restrict__ bias, bf16* XOB, int gw, int NGW, int lane_in) {
    int lane = lane_in; asm volatile("" : "+v"(lane));
    for (int row = gw; row < MTOK; row += NGW) {
        float v[4][8]; float s = 0.f;
#pragma unroll
        for (int j = 0; j < 4; ++j) { const u32x4 w = *(const u32x4*)(Y + (size_t)row * DM + 8 * (lane + 64 * j));
            v[j][0] = bflo(w[0]); v[j][1] = bfhi(w[0]); v[j][2] = bflo(w[1]); v[j][3] = bfhi(w[1]); v[j][4] = bflo(w[2]); v[j][5] = bfhi(w[2]); v[j][6] = bflo(w[3]); v[j][7] = bfhi(w[3]);
#pragma unroll
            for (int k = 0; k < 8; ++k) s += v[j][k]; }
        const float mean = wave_sum(s) * (1.0f / DM); float s2 = 0.f;
#pragma unroll
        for (int j = 0; j < 4; ++j)
#pragma unroll
            for (int k = 0; k < 8; ++k) { v[j][k] -= mean; s2 += v[j][k] * v[j][k]; }
        const float rstd = 1.0f / sqrtf(wave_sum(s2) * (1.0f / DM) + LN_EPS);
#pragma unroll
        for (int j = 0; j < 4; ++j) { const int col = 8 * (lane + 64 * j);
            const f32x4 g0 = *(const f32x4*)(gain + col), g1 = *(const f32x4*)(gain + col + 4), b0 = *(const f32x4*)(bias + col), b1 = *(const f32x4*)(bias + col + 4);
            u32x4 w; w.x = pk2(v[j][0] * rstd * g0[0] + b0[0], v[j][1] * rstd * g0[1] + b0[1]); w.y = pk2(v[j][2] * rstd * g0[2] + b0[2], v[j][3] * rstd * g0[3] + b0[3]);
            w.z = pk2(v[j][4] * rstd * g1[0] + b1[0], v[j][5] * rstd * g1[1] + b1[1]); w.w = pk2(v[j][6] * rstd * g1[2] + b1[2], v[j][7] * rstd * g1[3] + b1[3]);
            *(u32x4*)(XOB + (size_t)row * DM + col) = w; }
    }
}

DI unsigned fkey(float v) { const unsigned u = __builtin_bit_cast(unsigned, v); return (u & 0x80000000u) ? ~u : (u | 0x80000000u); }
DI float unkey(unsigned k) { const unsigned u = (k & 0x80000000u) ? (k ^ 0x80000000u) : ~k; return __builtin_bit_cast(float, u); }
DI unsigned umin2(unsigned a, unsigned b) { return a < b ? a : b; }
DI void sort16_desc(unsigned (&v)[16]) {
#pragma unroll
    for (int k = 2; k <= 16; k <<= 1)
#pragma unroll
        for (int j = k >> 1; j > 0; j >>= 1)
#pragma unroll
            for (int i = 0; i < 16; ++i) { const int l = i ^ j; if (l > i) { const unsigned a = v[i], b = v[l], hi = umax2(a, b), lo = umin2(a, b); if ((i & k) == 0) { v[i] = hi; v[l] = lo; } else { v[i] = lo; v[l] = hi; } } }
}
DI void merge16_desc(unsigned (&top)[16], const unsigned (&bt)[16]) {
#pragma unroll
    for (int i = 0; i < 16; ++i) top[i] = umax2(top[i], bt[15 - i]);
#pragma unroll
    for (int j = 8; j > 0; j >>= 1)
#pragma unroll
        for (int i = 0; i < 16; ++i) { const int l = i ^ j; if (l > i) { const unsigned a = top[i], b = top[l]; top[i] = umax2(a, b); top[l] = umin2(a, b); } }
}
DI void top16_row(const bf16* __restrict__ s, unsigned (&top)[16]) {
#pragma unroll
    for (int i = 0; i < 16; ++i) top[i] = 0u;
    for (int b = 0; b < 8; ++b) {
        unsigned bt[16];
#pragma unroll
        for (int q = 0; q < 2; ++q) { const u32x4 v = *(const u32x4*)(s + 16 * b + 8 * q);
#pragma unroll
            for (int e = 0; e < 4; ++e) { bt[8 * q + 2 * e] = (fkey(bflo(v[e])) & ~127u) | (unsigned)(16 * b + 8 * q + 2 * e); bt[8 * q + 2 * e + 1] = (fkey(bfhi(v[e])) & ~127u) | (unsigned)(16 * b + 8 * q + 2 * e + 1); } }
        sort16_desc(bt);
        merge16_desc(top, bt);
    }
}
DI unsigned cand_key(unsigned k1, unsigned k2) { const float s = unkey(k1 & ~127u) + unkey(k2 & ~127u); return (fkey(s) & ~0x3FFFu) | ((k1 & 127u) << 7) | (k2 & 127u); }
DI void peer_topk(const bf16* __restrict__ SC, int* IDX, float* G, int gw, int NGW, int lane_in) {
    int lane = lane_in; asm volatile("" : "+v"(lane));
    for (int wt = gw; wt < MTOK * 8 / 64; wt += NGW) {
        const int tk_ = lane >> 3, task_ = wt + (tk_ >> 2) * (MTOK / 8), item = (4 * task_ + (tk_ & 3)) * 8 + (lane & 7);
        const bf16* s = SC + (size_t)item * 256;
        unsigned k1[16], k2[16];
        top16_row(s, k1);
        top16_row(s + 128, k2);
        unsigned top[16], bt[16];
#pragma unroll
        for (int b = 0; b < 16; ++b) top[b] = cand_key(k1[0], k2[b]);
#pragma unroll
        for (int a = 1; a < 16; ++a) bt[a - 1] = cand_key(k1[a], k2[0]);
        bt[15] = 0u;
        merge16_desc(top, bt);
        bt[0] = cand_key(k1[1], k2[1]); bt[1] = cand_key(k1[1], k2[2]); bt[2] = cand_key(k1[1], k2[3]); bt[3] = cand_key(k1[1], k2[4]); bt[4] = cand_key(k1[1], k2[5]); bt[5] = cand_key(k1[1], k2[6]); bt[6] = cand_key(k1[1], k2[7]);
        bt[7] = cand_key(k1[2], k2[1]); bt[8] = cand_key(k1[2], k2[2]); bt[9] = cand_key(k1[2], k2[3]); bt[10] = cand_key(k1[2], k2[4]);
        bt[11] = cand_key(k1[3], k2[1]); bt[12] = cand_key(k1[3], k2[2]); bt[13] = cand_key(k1[3], k2[3]);
        bt[14] = cand_key(k1[4], k2[1]); bt[15] = cand_key(k1[4], k2[2]);
        sort16_desc(bt); merge16_desc(top, bt);
        bt[0] = cand_key(k1[5], k2[1]); bt[1] = cand_key(k1[6], k2[1]); bt[2] = cand_key(k1[7], k2[1]);
#pragma unroll
        for (int i = 3; i < 16; ++i) bt[i] = 0u;
        merge16_desc(top, bt);
        float ev[16]; float sum = 0.f; const float mx = unkey(top[0] & ~0x3FFFu);
#pragma unroll
        for (int i = 0; i < 16; ++i) { ev[i] = __expf(unkey(top[i] & ~0x3FFFu) - mx); sum += ev[i]; }
        const float rs = 1.0f / sum;
#pragma unroll
        for (int q = 0; q < 4; ++q) {
            *(u32x4*)(IDX + (size_t)item * 16 + 4 * q) = (u32x4){top[4 * q] & 0x3FFFu, top[4 * q + 1] & 0x3FFFu, top[4 * q + 2] & 0x3FFFu, top[4 * q + 3] & 0x3FFFu};
            *(f32x4*)(G + (size_t)item * 16 + 4 * q) = (f32x4){ev[4 * q] * rs, ev[4 * q + 1] * rs, ev[4 * q + 2] * rs, ev[4 * q + 3] * rs}; }
    }
}

typedef int i32x8 __attribute__((ext_vector_type(8)));
constexpr int UD_TOK = 4, UD_TS = 2064, UD_XS = UD_TOK * UD_TS, UD_LIST = 256, UD_SA = 272, UD_SB = 144, UD_STG = 16 * UD_SA + 16 * UD_SB, UD_DOT = UD_TOK * 128 * 4, UD_WAVE_LDS = UD_XS + UD_LIST * 4 + UD_STG + UD_DOT;
constexpr int UD_NR = 5, VS_RSH = 14, VS_NR = 16384 >> VS_RSH;
constexpr int UD_NBSP = 3;
DI void udots_groups(const unsigned char* __restrict__ UQ, LAS float* dl, const i32x8 (&Bf)[4 * UD_NBSP], LAS const unsigned char* xs, LAS unsigned* list, LAS unsigned char* stg, int n, int lane) {
    const int r = lane & 15, kg = lane >> 4;
    const int ngr = (n + 15) >> 4;
    if (ngr == 0) return;
    const unsigned long long uqa_ = (unsigned long long)UQ;
    const unsigned char* UQs = (const unsigned char*)(((unsigned long long)(unsigned)__builtin_amdgcn_readfirstlane((int)(uqa_ >> 32)) << 32) | (unsigned long long)(unsigned)__builtin_amdgcn_readfirstlane((int)uqa_));
    LAS unsigned char* stgA = stg; LAS unsigned char* stgB = stg + 16 * UD_SA;
    unsigned la[4], lb[2], na[4], nb[2];
    u32x4 Ra[6], Rb[6];
#if U_FP4
#define UD_ROWS(o4, o2, g_) do { const int gg_ = (g_) < ngr ? (g_) : ngr - 1; \
        _Pragma("unroll") for (int j_ = 0; j_ < 4; ++j_) (o4)[j_] = (list[16 * gg_ + 4 * j_ + (lane >> 4)] & 0x3FFFu) * 1024u + 16u * (lane & 15); } while (0)
#define UD_LOAD(R, o4, o2, sp_) do { \
        _Pragma("unroll") for (int j_ = 0; j_ < 4; ++j_) (R)[j_] = *(const u32x4*)(UQs + (o4)[j_] + 256 * (sp_)); } while (0)
#define UD_STEP(R, sp_, NEXTLOAD) do { \
        _Pragma("unroll") for (int j_ = 0; j_ < 4; ++j_) *(LAS u32x4*)(stgA + (4 * j_ + (lane >> 4)) * UD_SA + 16 * (lane & 15)) = (R)[j_]; \
        __builtin_amdgcn_sched_barrier(0); NEXTLOAD; __builtin_amdgcn_sched_barrier(0); \
        LDS_WAIT(); \
        _Pragma("unroll") for (int k4_ = 0; k4_ < 4; ++k4_) { \
            const u32x4 a4_ = *(const LAS u32x4*)(stgA + r * UD_SA + 16 * (4 * k4_ + kg)); \
            const i32x8 A_ = {(int)a4_[0], (int)a4_[1], (int)a4_[2], (int)a4_[3], 0, 0, 0, 0}; \
            i32x8 B_; if ((sp_) < UD_NBSP) B_ = Bf[((sp_) < UD_NBSP ? 4 * (sp_) + k4_ : 0)]; else { LAS const unsigned char* xb_ = xs + (r & 3) * UD_TS; const int ks_ = 4 * (sp_) + k4_; \
                const u32x4 b0_ = *(const LAS u32x4*)(xb_ + 32 * (4 * ks_ + (kg >> 1)) + 16 * (kg & 1)), b1_ = *(const LAS u32x4*)(xb_ + 32 * (4 * ks_ + 2 + (kg >> 1)) + 16 * (kg & 1)); \
                B_ = (i32x8){(int)b0_[0], (int)b0_[1], (int)b0_[2], (int)b0_[3], (int)b1_[0], (int)b1_[1], (int)b1_[2], (int)b1_[3]}; } \
            acc = __builtin_amdgcn_mfma_scale_f32_16x16x128_f8f6f4(A_, B_, acc, 4  , 0  , 0, 127, 0, 127); } \
        LDS_WAIT(); } while (0)
#else
#define UD_ROWS(o4, o2, g_) do { const int gg_ = (g_) < ngr ? (g_) : ngr - 1; \
        _Pragma("unroll") for (int j_ = 0; j_ < 4; ++j_) (o4)[j_] = (list[16 * gg_ + 4 * j_ + (lane >> 4)] & 0x3FFFu) * 1536u + 16u * (lane & 15); \
        _Pragma("unroll") for (int j_ = 0; j_ < 2; ++j_) (o2)[j_] = (list[16 * gg_ + 8 * j_ + (lane >> 3)] & 0x3FFFu) * 1536u + 1024u + 16u * (lane & 7); } while (0)
#define UD_LOAD(R, o4, o2, sp_) do { \
        _Pragma("unroll") for (int j_ = 0; j_ < 4; ++j_) (R)[j_] = *(const u32x4*)(UQs + (o4)[j_] + 256 * (sp_)); \
        _Pragma("unroll") for (int j_ = 0; j_ < 2; ++j_) (R)[4 + j_] = *(const u32x4*)(UQs + (o2)[j_] + 128 * (sp_)); } while (0)
#define UD_STEP(R, sp_, NEXTLOAD) do { \
        _Pragma("unroll") for (int j_ = 0; j_ < 4; ++j_) *(LAS u32x4*)(stgA + (4 * j_ + (lane >> 4)) * UD_SA + 16 * (lane & 15)) = (R)[j_]; \
        _Pragma("unroll") for (int j_ = 0; j_ < 2; ++j_) *(LAS u32x4*)(stgB + (8 * j_ + (lane >> 3)) * UD_SB + 16 * (lane & 7)) = (R)[4 + j_]; \
        __builtin_amdgcn_sched_barrier(0); NEXTLOAD; __builtin_amdgcn_sched_barrier(0);     \
        LDS_WAIT(); \
        _Pragma("unroll") for (int k4_ = 0; k4_ < 4; ++k4_) { \
            const u32x4 a4_ = *(const LAS u32x4*)(stgA + r * UD_SA + 16 * (4 * k4_ + kg)); const u32x2 a2_ = *(const LAS u32x2*)(stgB + r * UD_SB + 8 * (4 * k4_ + kg)); \
            const i32x8 A_ = {(int)a4_[0], (int)a4_[1], (int)a4_[2], (int)a4_[3], (int)a2_[0], (int)a2_[1], 0, 0}; \
            i32x8 B_; if ((sp_) < UD_NBSP) B_ = Bf[((sp_) < UD_NBSP ? 4 * (sp_) + k4_ : 0)]; else { LAS const unsigned char* xb_ = xs + (r & 3) * UD_TS; const int ks_ = 4 * (sp_) + k4_; \
                const u32x4 b0_ = *(const LAS u32x4*)(xb_ + 32 * (4 * ks_ + (kg >> 1)) + 16 * (kg & 1)), b1_ = *(const LAS u32x4*)(xb_ + 32 * (4 * ks_ + 2 + (kg >> 1)) + 16 * (kg & 1)); \
                B_ = (i32x8){(int)b0_[0], (int)b0_[1], (int)b0_[2], (int)b0_[3], (int)b1_[0], (int)b1_[1], (int)b1_[2], (int)b1_[3]}; } \
            acc = __builtin_amdgcn_mfma_scale_f32_16x16x128_f8f6f4(A_, B_, acc, 2  , 0  , 0, 127, 0, 127); } \
        LDS_WAIT(); } while (0)
#endif
    UD_ROWS(la, lb, 0); UD_LOAD(Ra, la, lb, 0); UD_LOAD(Rb, la, lb, 1);
#pragma unroll 1
    for (int g = 0; g < ngr; ++g) {
        f32x4 acc = (f32x4){0.f, 0.f, 0.f, 0.f};
        UD_ROWS(na, nb, g + 1);
        UD_STEP(Ra, 0, UD_LOAD(Ra, la, lb, 2));
        UD_STEP(Rb, 1, UD_LOAD(Rb, la, lb, 3));
        UD_STEP(Ra, 2, UD_LOAD(Ra, na, nb, 0));
        UD_STEP(Rb, 3, UD_LOAD(Rb, na, nb, 1));
        const u32x4 en = *(const LAS u32x4*)(list + 16 * g + 4 * kg);
#pragma unroll
        for (int j = 0; j < 4; ++j) { const unsigned e4 = en[j]; if (!(e4 >> 31) && (int)((e4 >> 21) & 7u) == r) dl[r * 128 + ((e4 >> 14) & 127u)] = acc[j]; }
#pragma unroll
        for (int j = 0; j < 4; ++j) la[j] = na[j];
        lb[0] = nb[0]; lb[1] = nb[1];
    }
#undef UD_ROWS
#undef UD_LOAD
#undef UD_STEP
}
DI void peer_udots_mfma(const bf16* __restrict__ X1, const int* __restrict__ IDX, const unsigned char* __restrict__ UQ, float* __restrict__ DOT, LAS unsigned char* wlds, int gw, int NGW, int lane_in) {
    int lane = lane_in; asm volatile("" : "+v"(lane));
    LAS unsigned char* xs = wlds; LAS unsigned* list = (LAS unsigned*)(wlds + UD_XS);
    LAS unsigned char* stg = wlds + UD_XS + UD_LIST * 4; LAS float* dl = (LAS float*)(wlds + UD_XS + UD_LIST * 4 + UD_STG);
    const int r = lane & 15, kg = lane >> 4;
    for (int task = gw; task < MTOK / UD_TOK; task += NGW) {
        const int t0 = task * UD_TOK;
#pragma unroll
        for (int tok = 0; tok < UD_TOK; ++tok) { unsigned pw[8];
#pragma unroll
            for (int q = 0; q < 8; ++q) { const u32x2 v = *(const u32x2*)(X1 + (size_t)(t0 + tok) * DM + 4 * (lane + 64 * q));
                int w = 0; w = __builtin_amdgcn_cvt_pk_fp8_f32(bflo(v[0]), bfhi(v[0]), w, false); w = __builtin_amdgcn_cvt_pk_fp8_f32(bflo(v[1]), bfhi(v[1]), w, true); pw[q] = (unsigned)w; }
            *(LAS u32x4*)(xs + tok * UD_TS + 32 * lane) = (u32x4){pw[0], pw[1], pw[2], pw[3]}; *(LAS u32x4*)(xs + tok * UD_TS + 32 * lane + 16) = (u32x4){pw[4], pw[5], pw[6], pw[7]};
        }
        LDS_WAIT();
        i32x8 Bf[4 * UD_NBSP];
#pragma unroll
        for (int ks = 0; ks < 4 * UD_NBSP; ++ks) { LAS const unsigned char* xb = xs + (r & 3) * UD_TS;
            const u32x4 b0 = *(const LAS u32x4*)(xb + 32 * (4 * ks + (kg >> 1)) + 16 * (kg & 1)), b1 = *(const LAS u32x4*)(xb + 32 * (4 * ks + 2 + (kg >> 1)) + 16 * (kg & 1));
            Bf[ks] = (i32x8){(int)b0[0], (int)b0[1], (int)b0[2], (int)b0[3], (int)b1[0], (int)b1[1], (int)b1[2], (int)b1[3]}; }
        LDS_WAIT();
#pragma unroll
        for (int tok = 0; tok < UD_TOK; ++tok) { LAS int* idl = (LAS int*)(xs + tok * UD_TS); idl[lane] = IDX[(size_t)(t0 + tok) * 128 + lane]; idl[64 + lane] = IDX[(size_t)(t0 + tok) * 128 + 64 + lane]; }
        LDS_WAIT();
#pragma unroll 1
        for (int s = 0; s < UD_NR; ++s) {
            int n = 0;
#pragma unroll
            for (int tok = 0; tok < UD_TOK; ++tok) {
                const LAS int* idl = (const LAS int*)(xs + tok * UD_TS); const int id0 = idl[lane], id1 = idl[64 + lane];
                const bool m0 = ((id0 * UD_NR) >> 14) == s, m1 = ((id1 * UD_NR) >> 14) == s;
                const unsigned long long b0 = __ballot(m0), b1 = __ballot(m1);
                const unsigned long long lt = (1ull << lane) - 1ull;
                const int c0 = __popcll(b0), c1 = __popcll(b1);
                if (n + c0 + c1 > UD_LIST - 16) {
                    for (int i = n + lane; i < ((n + 15) & ~15); i += 64) list[i] = 0x80000000u;
                    LDS_WAIT(); udots_groups(UQ, dl, Bf, xs, list, stg, n, lane); LDS_WAIT(); n = 0; }
                if (m0) list[n + __popcll(b0 & lt)] = (unsigned)id0 | ((unsigned)lane << 14) | ((unsigned)tok << 21);
                if (m1) list[n + c0 + __popcll(b1 & lt)] = (unsigned)id1 | ((unsigned)(lane + 64) << 14) | ((unsigned)tok << 21);
                n += c0 + c1;
            }
            for (int i = n + lane; i < ((n + 15) & ~15); i += 64) list[i] = 0x80000000u;
            LDS_WAIT();
            udots_groups(UQ, dl, Bf, xs, list, stg, n, lane);
            LDS_WAIT();
        }
#pragma unroll
        for (int j = 0; j < 8; ++j) DOT[(size_t)t0 * 128 + lane + 64 * j] = dl[lane + 64 * j];
        LDS_WAIT();
    }
}

DI float gelu_exact(float x) { return 0.5f * x * (1.0f + erff(x * 0.7071067811865476f)); }
constexpr int VS_TOK = 2, VS_CAP = 320;
template <bool LAST> DI void peer_vsweep_ln(const bf16* __restrict__ X1, const int* __restrict__ IDX, const float* __restrict__ G, const float* __restrict__ DOT, const unsigned char* __restrict__ VQ,
                       const float* __restrict__ SU, const float* __restrict__ SV, const float* __restrict__ gain, const float* __restrict__ bias, float* XO, bf16* XOB, unsigned char* X8O, LAS unsigned char* wlds, int gw, int NGW, int task_end, int lane_in) {
    int lane = lane_in; asm volatile("" : "+v"(lane));
    LAS unsigned* list = (LAS unsigned*)wlds; LAS unsigned* wl = (LAS unsigned*)(wlds + VS_CAP * 4); LAS unsigned* segc = (LAS unsigned*)(wlds + VS_CAP * 8);
    typedef _Float16 h2 __attribute__((ext_vector_type(2)));
    for (int task = gw; task < task_end; task += NGW) {
        const int t0 = task * VS_TOK;
        int ids[VS_TOK][2]; float wts[VS_TOK][2];
#pragma unroll
        for (int tok = 0; tok < VS_TOK; ++tok) { const size_t b = (size_t)(t0 + tok) * 128;
            ids[tok][0] = IDX[b + lane]; ids[tok][1] = IDX[b + 64 + lane];
            wts[tok][0] = G[b + lane] * SV[ids[tok][0]] * gelu_exact(DOT[b + lane] * SU[ids[tok][0]]);
            wts[tok][1] = G[b + 64 + lane] * SV[ids[tok][1]] * gelu_exact(DOT[b + 64 + lane] * SU[ids[tok][1]]); }
        h2 acc[VS_TOK][16];
#pragma unroll
        for (int tok = 0; tok < VS_TOK; ++tok)
#pragma unroll
            for (int k = 0; k < 16; ++k) acc[tok][k] = (h2){(_Float16)0.f, (_Float16)0.f};
        int n = 0;
#pragma unroll 1
        for (int s = 0; s < VS_NR; ++s) {
#pragma unroll
            for (int tok = 0; tok < VS_TOK; ++tok) {
                const bool m0 = (ids[tok][0] >> VS_RSH) == s, m1 = (ids[tok][1] >> VS_RSH) == s;
                const unsigned long long b0 = __ballot(m0), b1 = __ballot(m1); const unsigned long long lt = (1ull << lane) - 1ull;
                const int c0 = __popcll(b0), c1 = __popcll(b1), c = c0 + c1, cp = (c + 3) & ~3;
                if (m0) { const int p = n + __popcll(b0 & lt); list[p] = (unsigned)ids[tok][0]; const h2 t = {(_Float16)wts[tok][0], (_Float16)wts[tok][0]}; wl[p] = __builtin_bit_cast(unsigned, t); }
                if (m1) { const int p = n + c0 + __popcll(b1 & lt); list[p] = (unsigned)ids[tok][1]; const h2 t = {(_Float16)wts[tok][1], (_Float16)wts[tok][1]}; wl[p] = __builtin_bit_cast(unsigned, t); }
                if (lane < cp - c) { list[n + c + lane] = 0u; wl[n + c + lane] = 0u; }
                if (lane == 0) segc[s * VS_TOK + tok] = (unsigned)(cp >> 2);
                n += cp;
            }
        }
        LDS_WAIT();
        {
            const int ngp = n >> 2;
            u32x4 A4[4], B4[4], C4[4];
#define VS_LOAD(b4, g_) do { const int gg_ = (g_) < ngp ? (g_) : (ngp > 0 ? ngp - 1 : 0); const u32x4 i4_ = *(const LAS u32x4*)(list + 4 * gg_); _Pragma("unroll") for (int j_ = 0; j_ < 4; ++j_) { \
            const unsigned idx_ = (unsigned)__builtin_amdgcn_readfirstlane((int)i4_[j_]); (b4)[j_] = *(const u32x4*)(VQ + (size_t)idx_ * 1024 + 16 * lane); } } while (0)
#define VS_PROC(b4, g_) do { const u32x4 w4_ = *(const LAS u32x4*)(wl + 4 * (g_)); _Pragma("unroll") for (int j = 0; j < 4; ++j) { const h2 wh = __builtin_bit_cast(h2, (unsigned)__builtin_amdgcn_readfirstlane((int)w4_[j])); \
            _Pragma("unroll") for (int w = 0; w < 4; ++w) { \
                acc[tok][4 * w] += wh * __builtin_amdgcn_cvt_scalef32_pk_f16_fp4((b4)[j][w], 1.0f, 0); acc[tok][4 * w + 1] += wh * __builtin_amdgcn_cvt_scalef32_pk_f16_fp4((b4)[j][w], 1.0f, 1); \
                acc[tok][4 * w + 2] += wh * __builtin_amdgcn_cvt_scalef32_pk_f16_fp4((b4)[j][w], 1.0f, 2); acc[tok][4 * w + 3] += wh * __builtin_amdgcn_cvt_scalef32_pk_f16_fp4((b4)[j][w], 1.0f, 3); } } } while (0)
            if (ngp == 0 && lane < 4) list[lane] = 0u;
            VS_LOAD(A4, 0);
            int gs = 0;
#pragma unroll 1
            for (int s = 0; s < VS_NR; ++s) {
#pragma unroll
                for (int tok = 0; tok < VS_TOK; ++tok) {
                    const int ge = gs + __builtin_amdgcn_readfirstlane((int)segc[s * VS_TOK + tok]);
#pragma unroll 1
                    for (int g = gs; g < ge; ++g) {
                        VS_LOAD(B4, g + 1); VS_PROC(A4, g);
#pragma unroll
                        for (int j = 0; j < 4; ++j) { A4[j] = B4[j]; }
                    }
                    gs = ge;
                }
            }
#undef VS_PROC
#undef VS_LOAD
        }
        LDS_WAIT();
#pragma unroll
        for (int tok = 0; tok < VS_TOK; ++tok) { const int t = t0 + tok;
            float sm = 0.f; float y32[32];
#pragma unroll
            for (int k = 0; k < 16; ++k) { y32[2 * k] = (float)acc[tok][k][0]; y32[2 * k + 1] = (float)acc[tok][k][1]; }
#pragma unroll
            for (int q = 0; q < 8; ++q) { const u32x2 v = *(const u32x2*)(X1 + (size_t)t * DM + 4 * (lane + 64 * q));
                y32[4 * q] += DN_ALPHA * bflo(v[0]); y32[4 * q + 1] += DN_ALPHA * bfhi(v[0]); y32[4 * q + 2] += DN_ALPHA * bflo(v[1]); y32[4 * q + 3] += DN_ALPHA * bfhi(v[1]); }
#pragma unroll
            for (int k = 0; k < 32; ++k) sm += y32[k];
            const float mean = wave_sum(sm) * (1.0f / DM); float s2 = 0.f;
#pragma unroll
            for (int k = 0; k < 32; ++k) { y32[k] -= mean; s2 += y32[k] * y32[k]; }
            const float rstd = 1.0f / sqrtf(wave_sum(s2) * (1.0f / DM) + LN_EPS);
#pragma unroll
            for (int q = 0; q < 8; ++q) { const int col = 4 * (lane + 64 * q); const f32x4 ga = *(const f32x4*)(gain + col), ba = *(const f32x4*)(bias + col); f32x4 y;
                y[0] = y32[4 * q] * rstd * ga[0] + ba[0]; y[1] = y32[4 * q + 1] * rstd * ga[1] + ba[1]; y[2] = y32[4 * q + 2] * rstd * ga[2] + ba[2]; y[3] = y32[4 * q + 3] * rstd * ga[3] + ba[3];
                if constexpr (LAST) *(f32x4*)(XO + (size_t)t * DM + col) = y; else { *(u32x2*)(XOB + (size_t)t * DM + col) = (u32x2){pk2(y[0], y[1]), pk2(y[2], y[3])};
                    int w8 = 0; w8 = __builtin_amdgcn_cvt_pk_fp8_f32(y[0], y[1], w8, false); w8 = __builtin_amdgcn_cvt_pk_fp8_f32(y[2], y[3], w8, true); *(int*)(X8O + (size_t)t * DM + col) = w8; } } }
    }
}

#ifndef MK_ONE_LAUNCH
#define MK_ONE_LAUNCH 1
#endif
constexpr int N_PHASES = 19;
struct Args { const float* in[15]; float* out; unsigned char* ws; int ph_lo, ph_hi; };
__global__ void __launch_bounds__(NTHREADS, 2) fwd_kernel(Args args) {
    extern __shared__ __attribute__((aligned(16))) unsigned char lds_raw[];
    LAS unsigned char* lds = (LAS unsigned char*)lds_raw;
    volatile LAS unsigned* MISC = (volatile LAS unsigned*)(lds + MISC_OFF);
    const int tid = threadIdx.x, lane = tid & 63; const int wave = __builtin_amdgcn_readfirstlane(tid >> 6);
    const int G = gridDim.x; const int bx = blockIdx.x; const int vcu = (G % 8 == 0) ? (bx % 8) * (G / 8) + bx / 8 : bx;
    const int gw = vcu * NWAVES + wave, NGW = G * NWAVES;
    unsigned char* ws = args.ws;
    if (tid < 32) MISC[tid] = 0u;
    __syncthreads();
    const int lo = args.ph_lo, hi = args.ph_hi;
    XcdBarrier bar; bar.bar = (unsigned*)(ws + WS_CTL) + CW_BAR; bar.x = 0; bar.st = nullptr;
    if (hi - lo > 1) bar = xcd_barrier_post((unsigned*)(ws + WS_CTL) + CW_BAR, MISC + 8);
#define IN(k) (lo <= (k) && (k) < hi)
#define SEAM(k) do { if ((k) > lo) xcd_barrier(bar); } while (0)

    const float* x_in = args.in[0];
    bf16* XB = (bf16*)(ws + WS_XB); float* XF = (float*)(ws + WS_XF);
    bf16* Hb = (bf16*)(ws + WS_A); float* Yf = (float*)(ws + WS_A); bf16* QP = (bf16*)(ws + WS_A + 128 * MiB); float* SC = (float*)(ws + WS_A);
    bf16* QM = (bf16*)(ws + WS_B); bf16* KVM = (bf16*)(ws + WS_B + 48 * MiB); float* X1 = (float*)(ws + WS_B);
    unsigned char* ATT = ws + WS_C; bf16* X1B = (bf16*)(ws + WS_C);
    float* SSQ = (float*)(ws + WS_SSQ); int* IDX = (int*)(ws + WS_IDX); float* GT = (float*)(ws + WS_G);
    const float* T128 = (const float*)(ws + WS_T128); const float* T64 = (const float*)(ws + WS_T64);

    if (IN(0)) {
        ProArgs pa; pa.x = args.in[0]; pa.a_w_in = args.in[1]; pa.b_q_norm = args.in[2]; pa.b_w_q_b = args.in[3]; pa.b_kv_norm = args.in[4]; pa.b_w_kv_b = args.in[5]; pa.ab_w_out = args.in[6];
        pa.c_w_in = args.in[7]; pa.c_w_out = args.in[8]; pa.peer_w_query = args.in[9]; pa.peer_sub_keys = args.in[10]; pa.peer_u = args.in[11]; pa.peer_v = args.in[12]; pa.ws = ws;
        prologue(pa, lds, gw, NGW, wave, lane);
    }
#pragma unroll
    for (int layer = 0; layer < 2; ++layer) {
        const int pb = 1 + 9 * layer;
        float* xout = layer == 0 ? nullptr : args.out;
        bf16* xoutb = layer == 0 ? XB : nullptr;
        const float* ln_g = args.in[13] + (size_t)layer * 2 * DM; const float* ln_b = args.in[14] + (size_t)layer * 2 * DM;
        if (layer == 0) {
            if (IN(pb + 0)) { SEAM(pb + 0);
                pg8::Gemm g{(const bf16*)(ws + WS_X8), (const bf16*)(ws + WS_WIN0), MTOK, EVEN_INP, DM / 2, DM / 2, DM / 2, 0, 0}; pg8::StaticOrder S; S.init(MTOK, EVEN_INP, G, bx);
                pg8::EpiIn0 E{Hb, EVEN_INP, T128, T64, SSQ, SEQ};
                pg8::gemm_phase<pg8::EpiIn0, pg8::StaticOrder, true, false, true>(lds, g, S, E); }
            if (IN(pb + 1)) { SEAM(pb + 1);
#pragma unroll 1
                for (int l2 = 0; l2 < 2; ++l2) {
                    pg8::Gemm g{(const bf16*)(ws + WS_KB + (size_t)l2 * MiB), (const bf16*)(ws + WS_WPQ + (size_t)l2 * 8 * MiB), DM, DM, 256, 256, DM, 0, 256}; pg8::StaticOrder S; S.init(DM, DM, G, (bx + G - 128 - 64 * l2) % G);
                    pg8::EpiPlain E{(bf16*)(ws + WS_WS + (size_t)l2 * 8 * MiB), DM, 1.0f};
                    pg8::gemm_phase<pg8::EpiPlain, pg8::StaticOrder, true, true>(lds, g, S, E); __syncthreads(); }
                { pg8::Gemm g{Hb + 3072, (const bf16*)(ws + WS_WQB), MTOK, 1536, 512, EVEN_INP, 512, 0, 0}; pg8::StaticOrder S; S.init(MTOK, 1536, G, bx);
                  pg8::EpiMlaQ E{QM, 1536, T64, SSQ, SEQ};
                  pg8::gemm_phase<pg8::EpiMlaQ, pg8::StaticOrder, true, true>(lds, g, S, E); }
                __syncthreads();
                { pg8::Gemm g{Hb + 3584, (const bf16*)(ws + WS_WKVB), MTOK, 2048, 256, EVEN_INP, 256, 0, 0}; pg8::StaticOrder S; S.init(MTOK, 2048, G, bx);
                  pg8::EpiMlaKV E{KVM, 2048, SSQ};
                  pg8::gemm_phase<pg8::EpiMlaKV, pg8::StaticOrder, true, true>(lds, g, S, E); } }
            if (IN(pb + 2)) { SEAM(pb + 2);
                for (int ub = vcu; ub < 512; ub += G) { const int r16b = (ub & 1) * 8, mbk = (ub >> 1) & 15, hq = (ub >> 5) & 7, bq = ub >> 8;
                    att::dilated_block_unit(lds, bq, hq, r16b, mbk, Hb, ATT); }
                __syncthreads();
                for (int up = vcu; up < 256; up += G) { const int bh = up >> 4, s = up & 15;
                    att::mla_unit(lds, bh >> 3, bh & 7, s, QM, KVM, Hb, ATT); __syncthreads();
                    att::mla_unit(lds, bh >> 3, bh & 7, 31 - s, QM, KVM, Hb, ATT); __syncthreads(); } }
        } else {
            if (IN(pb + 0)) { SEAM(pb + 0);
                pg8::Gemm g{(const bf16*)(ws + WS_X8), (const bf16*)(ws + WS_W8IN1), MTOK, ODD_IN, DM / 2, DM / 2, DM / 2, 0, 0}; pg8::StaticOrder S; S.init(MTOK, ODD_IN, G, bx);
                pg8::EpiPlain E{Hb, ODD_IN, 1.0f};
                pg8::gemm_phase<pg8::EpiPlain, pg8::StaticOrder, true, false, true>(lds, g, S, E); }
            if (IN(pb + 2)) { SEAM(pb + 2);
                for (int u = vcu; u < 1024; u += G) { const int bh = u >> 5, qb = u & 31;
                    att::stick_unit(lds, bh >> 4, bh & 15, qb, Hb, ATT, true); } }
        }
        if (IN(pb + 3)) { SEAM(pb + 3);
            pg8::Gemm g{(const bf16*)ATT, (const bf16*)(ws + (layer == 0 ? WS_WOUT0 : WS_WOUT1)), MTOK, DM, DM / 2, DM / 2, DM / 2, 0, 0}; pg8::StaticOrder S; S.init(MTOK, DM, G, bx);
            pg8::EpiResB E{XB, (bf16*)Yf, DM, DN_ALPHA};
            pg8::gemm_phase<pg8::EpiResB, pg8::StaticOrder, true, false, true>(lds, g, S, E); }
        if (IN(pb + 4)) { SEAM(pb + 4); ln_rows_b((const bf16*)Yf, ln_g, ln_b, X1B, gw, NGW, lane); }
        if (IN(pb + 5)) { SEAM(pb + 5);
            pg8::Gemm g{X1B, (const bf16*)(ws + WS_WS + (size_t)layer * 8 * MiB), MTOK, DM, DM, DM, DM, 0, 0}; pg8::StaticOrder S; S.init(MTOK, DM, G, bx);
            pg8::EpiPlain E{(bf16*)SC, DM, 1.0f};
            pg8::gemm_phase<pg8::EpiPlain, pg8::StaticOrder, true, true>(lds, g, S, E); }
        float* DOT = (float*)(ws + WS_A + 128 * MiB);
        if (IN(pb + 6)) { SEAM(pb + 6);
#pragma unroll 1
            for (int st = gw; st < MTOK / 8; st += NGW) {
                peer_topk((const bf16*)SC, IDX, GT, st, MTOK / 8, lane);
                asm volatile("s_waitcnt vmcnt(0)" ::: "memory");
                peer_udots_mfma(X1B, IDX, ws + WS_UV + (size_t)layer * 48 * MiB, DOT, lds + wave * UD_WAVE_LDS, st, MTOK / 8, lane);
                asm volatile("s_waitcnt vmcnt(0)" ::: "memory");
#pragma unroll 1
                for (int hf = 0; hf < 2; ++hf) { const int tk0 = (4 / VS_TOK) * (st + hf * (MTOK / 8));
                    if (layer == 0) peer_vsweep_ln<false>(X1B, IDX, GT, DOT, ws + WS_UV + (size_t)layer * 48 * MiB + 24 * MiB, (const float*)(ws + WS_QS) + (size_t)layer * 2 * NEXP, (const float*)(ws + WS_QS) + (size_t)layer * 2 * NEXP + NEXP,
                                   ln_g + DM, ln_b + DM, xout, xoutb, ws + WS_X8, lds + wave * UD_WAVE_LDS, tk0, 1, tk0 + 4 / VS_TOK, lane);
                    else peer_vsweep_ln<true>(X1B, IDX, GT, DOT, ws + WS_UV + (size_t)layer * 48 * MiB + 24 * MiB, (const float*)(ws + WS_QS) + (size_t)layer * 2 * NEXP, (const float*)(ws + WS_QS) + (size_t)layer * 2 * NEXP + NEXP,
                                   ln_g + DM, ln_b + DM, xout, xoutb, ws + WS_X8, lds + wave * UD_WAVE_LDS, tk0, 1, tk0 + 4 / VS_TOK, lane); } } }
    }
#undef IN
#undef SEAM
}

extern "C" void kernel_launch(void* const* d_in, const int* in_sizes, int n_in, void* d_out, int out_size, void* d_ws, size_t ws_size, hipStream_t stream) {
    static int grid = 0;
    if (grid == 0) {
        if (n_in != 15 || in_sizes[0] != MTOK * DM || out_size != MTOK * DM || ws_size < WS_END) {
            fprintf(stderr, "kernel_launch: unexpected shapes: n_in %d in0 %d out %d ws %zu (need %zu); nothing launched\n", n_in, n_in > 0 ? in_sizes[0] : -1, out_size, ws_size, (size_t)WS_END); grid = -1; return; }
        int dev = 0, cus = 0, per_cu = 0;
        if (hipGetDevice(&dev) != hipSuccess || hipDeviceGetAttribute(&cus, hipDeviceAttributeMultiprocessorCount, dev) != hipSuccess) { fprintf(stderr, "kernel_launch: device query failed\n"); grid = -1; return; }
        if (hipFuncSetAttribute((const void*)fwd_kernel, hipFuncAttributeMaxDynamicSharedMemorySize, LDS_BYTES) != hipSuccess) { fprintf(stderr, "kernel_launch: hipFuncSetAttribute failed\n"); grid = -1; return; }
        if (hipOccupancyMaxActiveBlocksPerMultiprocessor(&per_cu, (const void*)fwd_kernel, NTHREADS, LDS_BYTES) != hipSuccess || per_cu < 1)
            fprintf(stderr, "kernel_launch: note: occupancy query reports %d workgroups per CU\n", per_cu);
        (void)hipGetLastError();
        grid = cus;
    }
    if (grid < 0) return;
    if (hipMemsetAsync((char*)d_ws + WS_CTL, 0, CTL_ZERO_BYTES, stream) != hipSuccess) { fprintf(stderr, "kernel_launch: memset failed\n"); return; }
    Args a{};
    for (int i = 0; i < 15; ++i) a.in[i] = (const float*)d_in[i];
    a.out = (float*)d_out; a.ws = (unsigned char*)d_ws;
#if MK_ONE_LAUNCH
    a.ph_lo = 0; a.ph_hi = N_PHASES;
    hipLaunchKernelGGL(fwd_kernel, dim3(grid), dim3(NTHREADS), LDS_BYTES, stream, a);
#endif
    const hipError_t le = hipPeekAtLastError();
    if (le != hipSuccess) fprintf(stderr, "kernel_launch: launch failed: %s\n", hipGetErrorName(le));
}
```
